# Optimizing an MI355X kernel written in HIP

```python
import functools
import jax, jax.numpy as jnp
from jax import lax
import numpy as np

D_MODEL = 1024
BATCH = 2
SEQ = 8192
DEPTH = 2

GRID_W = 64
CTX_LEN = 256
CHUNK = 64
ROPE_THETA = 10000.0

RET_HEADS = 4
RET_DH = 64
RET_W = RET_HEADS * RET_DH
GLA_HEADS = 4
GLA_DK = 48
GLA_DV = 96
GLA_KW = GLA_HEADS * GLA_DK
GLA_VW = GLA_HEADS * GLA_DV
GLA_RANK = 16
GLA_TAU = 16.0
RWKV_HEADS = 6
RWKV_DH = 64
RWKV_W = RWKV_HEADS * RWKV_DH
RWKV_W_RANK = 64
RWKV_A_RANK = 64
RWKV_G_RANK = 128

MIX_W = RET_W + GLA_VW + RWKV_W
RET_COLS = (RET_W, RET_W, RET_W, RET_W)
GLA_COLS = (GLA_KW, GLA_KW, GLA_VW, GLA_VW, GLA_RANK, GLA_RANK)
RWKV_COLS = (RWKV_W, RWKV_W, RWKV_W, RWKV_W_RANK, RWKV_W_RANK, RWKV_A_RANK, RWKV_G_RANK)
RET_IN = 4 * RET_W
GLA_IN = 2 * GLA_KW + 2 * GLA_VW + 2 * GLA_RANK
RWKV_IN = 3 * RWKV_W + 2 * RWKV_W_RANK + RWKV_A_RANK + RWKV_G_RANK
IN_W = RET_IN + GLA_IN + RWKV_IN
FFN_HIDDEN = -(-8 * D_MODEL // (3 * 256)) * 256

kernel_name = "hybrid_retnet_gla_rwkv7_prefix_dit_block"


def _split(u, widths):
    return jnp.split(u, [int(i) for i in np.cumsum(widths)[:-1]], axis=-1)


def _heads(u, n):
    b, t, w = u.shape
    return u.reshape(b, t, n, w // n).transpose(0, 2, 1, 3)


def _merge(o):
    b, h, t, d = o.shape
    return o.transpose(0, 2, 1, 3).reshape(b, t, h * d)


def _rmsnorm(x, g, eps=1e-6):
    xf = x.astype(jnp.float32)
    y = xf * lax.rsqrt(jnp.mean(xf * xf, axis=-1, keepdims=True) + eps)
    return (y * g.astype(jnp.float32)).astype(x.dtype)


def _norm_heads(o, eps):
    mu = jnp.mean(o, axis=-1, keepdims=True)
    var = jnp.mean(jnp.square(o - mu), axis=-1, keepdims=True)
    return (o - mu) * lax.rsqrt(var + eps)


def _modulate(h, shift, scale):
    return h * (1.0 + scale) + shift


def _swiglu(h, w_gate, w_up, w_down):
    return (jax.nn.silu(h @ w_gate) * (h @ w_up)) @ w_down


def _rope_2d(x, row, col):
    half = x.shape[-1] // 2
    nf = half // 2
    inv = ROPE_THETA ** (-jnp.arange(nf, dtype=jnp.float32) / nf)

    def rot(xh, pos):
        ang = pos[:, None] * inv
        cos, sin = jnp.cos(ang), jnp.sin(ang)
        x1, x2 = xh[..., :nf], xh[..., nf:]
        return jnp.concatenate([x1 * cos - x2 * sin, x1 * sin + x2 * cos], axis=-1)

    return jnp.concatenate([rot(x[..., :half], row), rot(x[..., half:], col)], axis=-1)


def _centred_conv(u, w):
    return lax.conv_general_dilated(
        u, w.astype(u.dtype)[:, None, :], window_strides=(1,), padding=((1, 1),),
        dimension_numbers=("NWC", "WIO", "NWC"), feature_group_count=u.shape[-1])


def _chunks(a):
    b, h, t, d = a.shape
    return a.reshape(b, h, t // CHUNK, CHUNK, d).transpose(2, 0, 1, 3, 4)


def _unchunk(o):
    n, b, h, c, d = o.shape
    return o.transpose(1, 2, 0, 3, 4).reshape(b, h, n * c, d)


def _flip(a):
    return jnp.flip(a, axis=2)


def _bidirectional(scan_f, scan_b, ctx_f, ctx_b, lat_f, lat_b, s0):
    oc_f, sc_f = scan_f(ctx_f, s0)
    oc_b, sc_b = scan_b(tuple(_flip(a) for a in ctx_b), s0)
    ol_f, _ = scan_f(lat_f, sc_f)
    ol_b, _ = scan_b(tuple(_flip(a) for a in lat_b), sc_b)
    return oc_f + _flip(oc_b), ol_f + _flip(ol_b)


def _retention_scan(seq, s0, log_gamma):
    pos = jnp.arange(CHUNK, dtype=jnp.float32)
    rel = pos[:, None] - pos[None, :]
    intra = jnp.where(rel >= 0, jnp.exp(log_gamma[:, None, None] * jnp.maximum(rel, 0.0)), 0.0)
    q_dec = jnp.exp(log_gamma[:, None] * (pos + 1.0))[:, :, None]
    k_dec = jnp.exp(log_gamma[:, None] * (CHUNK - 1.0 - pos))[:, :, None]
    c_dec = jnp.exp(log_gamma * CHUNK)[:, None, None]

    def step(s, blk):
        qb, kb, vb = blk
        sc = jnp.einsum("bhid,bhjd->bhij", qb, kb) * intra
        o = jnp.einsum("bhij,bhjv->bhiv", sc, vb) + jnp.einsum("bhid,bhdv->bhiv", qb * q_dec, s)
        s = s * c_dec + jnp.einsum("bhjd,bhjv->bhdv", kb * k_dec, vb)
        return s, o

    s, o = lax.scan(step, s0, tuple(_chunks(a) for a in seq))
    return _unchunk(o), s


def _gla_scan(seq, s0):
    causal = jnp.tril(jnp.ones((CHUNK, CHUNK), dtype=bool))

    def step(s, blk):
        qb, kb, vb, gb = blk
        cum = jnp.cumsum(gb, axis=2)
        rel = cum[:, :, :, None, :] - cum[:, :, None, :, :]
        decay = jnp.exp(jnp.where(causal[:, :, None], rel, -jnp.inf))
        sc = jnp.einsum("bhid,bhjd,bhijd->bhij", qb, kb, decay)
        o = jnp.einsum("bhij,bhjv->bhiv", sc, vb) + jnp.einsum("bhid,bhdv->bhiv", qb * jnp.exp(cum), s)
        last = cum[:, :, -1:, :]
        s = s * jnp.exp(last[:, :, 0, :, None]) + jnp.einsum("bhjd,bhjv->bhdv", kb * jnp.exp(last - cum), vb)
        return s, o

    s, o = lax.scan(step, s0, tuple(_chunks(a) for a in seq))
    return _unchunk(o), s


def _rwkv_scan(seq, s0):
    def step(s, inp):
        rt, wt, kt, vt, kkt, at = inp
        sa = jnp.einsum("bhvk,bhk->bhv", s, -kkt)
        s = s * wt[:, :, None, :] + sa[..., None] * (kkt * at)[:, :, None, :] + vt[..., None] * kt[:, :, None, :]
        return s, jnp.einsum("bhvk,bhk->bhv", s, rt)

    s, o = lax.scan(step, s0, tuple(jnp.moveaxis(a, 2, 0) for a in seq))
    return jnp.moveaxis(o, 0, 2), s


def _retention_mixer(u_ctx, u_lat, row, col, ret_norm, ctx_out):
    def prep(u, rotate):
        q, k, v, g = _split(u, RET_COLS)
        q, k, v = (_heads(a, RET_HEADS) for a in (q, k, v))
        if rotate:
            q, k = _rope_2d(q, row, col), _rope_2d(k, row, col)
        return (q, k * RET_DH ** -0.5, v), g

    seq_c, g_c = prep(u_ctx, False)
    seq_l, g_l = prep(u_lat, True)
    log_gamma = jnp.log1p(-jnp.exp2(-5.0 - jnp.arange(RET_HEADS, dtype=jnp.float32)))
    scan_f = functools.partial(_retention_scan, log_gamma=log_gamma)
    scan_b = functools.partial(_retention_scan, log_gamma=jnp.flip(log_gamma))
    s0 = jnp.zeros((u_lat.shape[0], RET_HEADS, RET_DH, RET_DH), jnp.float32)
    o_c, o_l = _bidirectional(scan_f, scan_b, seq_c, seq_c, seq_l, seq_l, s0)

    def finish(o, g):
        return jax.nn.silu(g) * (_merge(_norm_heads(o, 1e-5)) * ret_norm)

    return (finish(o_c, g_c) if ctx_out else None), finish(o_l, g_l)


def _gla_mixer(u_ctx, u_lat, wa2_f, ba_f, wa2_b, ba_b, gla_norm, ctx_out):
    def prep(u):
        q, k, v, g, lr_f, lr_b = _split(u, GLA_COLS)
        q = _heads(q, GLA_HEADS) * GLA_DK ** -0.5
        k = _heads(k, GLA_HEADS)
        v = _heads(v, GLA_HEADS)
        la_f = _heads(jax.nn.log_sigmoid(lr_f @ wa2_f + ba_f) / GLA_TAU, GLA_HEADS)
        la_b = _heads(jax.nn.log_sigmoid(lr_b @ wa2_b + ba_b) / GLA_TAU, GLA_HEADS)
        return (q, k, v, la_f), (q, k, v, la_b), g

    cf, cb, g_c = prep(u_ctx)
    lf, lb, g_l = prep(u_lat)
    s0 = jnp.zeros((u_lat.shape[0], GLA_HEADS, GLA_DK, GLA_DV), jnp.float32)
    o_c, o_l = _bidirectional(_gla_scan, _gla_scan, cf, cb, lf, lb, s0)

    def finish(o, g):
        y = o * lax.rsqrt(jnp.mean(o * o, axis=-1, keepdims=True) + 1e-5) * gla_norm
        return jax.nn.silu(g) * _merge(y)

    return (finish(o_c, g_c) if ctx_out else None), finish(o_l, g_l)


def _rwkv_mixer(u_ctx, u_lat, conv_w, w0_f, w2_f, w0_b, w2_b, a0, a2, g2, k_k, k_a, r_k, ln_w, ln_b, ctx_out):
    def decay(lr, w0, w2):
        log_w = -jax.nn.softplus(-(w0 + jnp.tanh(lr) @ w2)) - 0.5
        return jnp.exp(-jnp.exp(log_w))

    def prep(u):
        u = _centred_conv(u, conv_w)
        r, k, v, lr_wf, lr_wb, lr_a, lr_g = _split(u, RWKV_COLS)
        a = jax.nn.sigmoid(a0 + lr_a @ a2)
        g = jax.nn.sigmoid(lr_g) @ g2
        kk = _heads(k * k_k, RWKV_HEADS)
        kk = kk * lax.rsqrt(jnp.maximum(jnp.sum(kk * kk, axis=-1, keepdims=True), 1e-24))
        k = k * (1.0 + (a - 1.0) * k_a)
        r, k, v, a = (_heads(t, RWKV_HEADS) for t in (r, k, v, a))
        wf = _heads(decay(lr_wf, w0_f, w2_f), RWKV_HEADS)
        wb = _heads(decay(lr_wb, w0_b, w2_b), RWKV_HEADS)
        bonus = jnp.sum(r * k * r_k[:, None, :], axis=-1, keepdims=True) * v
        return (r, wf, k, v, kk, a), (r, wb, k, v, kk, a), g, bonus

    cf, cb, g_c, bo_c = prep(u_ctx)
    lf, lb, g_l, bo_l = prep(u_lat)
    s0 = jnp.zeros((u_lat.shape[0], RWKV_HEADS, RWKV_DH, RWKV_DH), jnp.float32)
    o_c, o_l = _bidirectional(_rwkv_scan, _rwkv_scan, cf, cb, lf, lb, s0)

    def finish(o, g, bonus):
        y = _merge(_norm_heads(o, 64e-5)) * ln_w + ln_b + _merge(bonus)
        return y * g

    return (finish(o_c, g_c, bo_c) if ctx_out else None), finish(o_l, g_l, bo_l)


def setup_inputs(seed: int = 0) -> dict:
    key = jax.random.key(seed)
    keys = iter(jax.random.split(key, 48))
    L, D = DEPTH, D_MODEL

    def rnd(shape, scale):
        return jax.random.normal(next(keys), shape, jnp.float32) * scale

    def gain(shape):
        return 1.0 + rnd(shape, 0.02)

    decay_base = jnp.linspace(-6.5, -1.5, RWKV_W, dtype=jnp.float32)[None, :]
    shift_taps = jnp.array([0.0, 1.0, 0.0], jnp.float32)[None, :, None]
    return {
        "x": rnd((BATCH, SEQ, D), 1.0),
        "c": rnd((BATCH, D), 1.0),
        "ctx": rnd((BATCH, CTX_LEN, D), 1.0),
        "c_ctx": rnd((D,), 1.0),
        "w_mod": rnd((L, D, 6 * D), D ** -0.5),
        "b_mod": rnd((L, 6 * D), 0.02),
        "norm_mix_pre": gain((L, D)),
        "norm_mix_post": gain((L, D)),
        "norm_ffn_pre": gain((L, D)),
        "norm_ffn_post": gain((L, D)),
        "w_in": rnd((L, D, IN_W), D ** -0.5),
        "ret_norm": gain((L, RET_W)),
        "gla_wa2_f": rnd((L, GLA_RANK, GLA_KW), GLA_RANK ** -0.5),
        "gla_ba_f": rnd((L, GLA_KW), 0.1),
        "gla_wa2_b": rnd((L, GLA_RANK, GLA_KW), GLA_RANK ** -0.5),
        "gla_ba_b": rnd((L, GLA_KW), 0.1),
        "gla_norm": gain((L, GLA_DV)),
        "rw_conv": rnd((L, 3, RWKV_IN), 0.2) + shift_taps,
        "rw_w0_f": decay_base + rnd((L, RWKV_W), 0.1),
        "rw_w2_f": rnd((L, RWKV_W_RANK, RWKV_W), 0.1),
        "rw_w0_b": decay_base + rnd((L, RWKV_W), 0.1),
        "rw_w2_b": rnd((L, RWKV_W_RANK, RWKV_W), 0.1),
        "rw_a0": rnd((L, RWKV_W), 0.1),
        "rw_a2": rnd((L, RWKV_A_RANK, RWKV_W), 0.5 * RWKV_A_RANK ** -0.5),
        "rw_g2": rnd((L, RWKV_G_RANK, RWKV_W), RWKV_G_RANK ** -0.5),
        "rw_k_k": 0.85 + rnd((L, RWKV_W), 0.02),
        "rw_k_a": 1.0 + rnd((L, RWKV_W), 0.02),
        "rw_r_k": rnd((L, RWKV_HEADS, RWKV_DH), 0.1),
        "rw_ln_w": gain((L, RWKV_W)),
        "rw_ln_b": rnd((L, RWKV_W), 0.02),
        "w_out": rnd((L, MIX_W, D), MIX_W ** -0.5),
        "w_ffn_gate": rnd((L, D, FFN_HIDDEN), D ** -0.5),
        "w_ffn_up": rnd((L, D, FFN_HIDDEN), D ** -0.5),
        "w_ffn_down": rnd((L, FFN_HIDDEN, D), FFN_HIDDEN ** -0.5),
    }


def reference(x, c, ctx, c_ctx, w_mod, b_mod, norm_mix_pre, norm_mix_post, norm_ffn_pre, norm_ffn_post,
              w_in, ret_norm, gla_wa2_f, gla_ba_f, gla_wa2_b, gla_ba_b, gla_norm, rw_conv,
              rw_w0_f, rw_w2_f, rw_w0_b, rw_w2_b, rw_a0, rw_a2, rw_g2, rw_k_k, rw_k_a, rw_r_k,
              rw_ln_w, rw_ln_b, w_out, w_ffn_gate, w_ffn_up, w_ffn_down):
    t = x.shape[1]
    rows = t // GRID_W
    row = jnp.repeat(jnp.arange(rows, dtype=jnp.float32), GRID_W)
    col = jnp.tile(jnp.arange(GRID_W, dtype=jnp.float32), rows)

    for l in range(DEPTH):
        ctx_out = l < DEPTH - 1
        mod_l = jax.nn.silu(c) @ w_mod[l] + b_mod[l]
        mod_c = jax.nn.silu(c_ctx) @ w_mod[l] + b_mod[l]
        sh1, sc1, gt1, sh2, sc2, gt2 = jnp.split(mod_l[:, None, :], 6, axis=-1)
        csh1, csc1, cgt1, csh2, csc2, cgt2 = jnp.split(mod_c[None, None, :], 6, axis=-1)

        u_lat = (_modulate(_rmsnorm(x, norm_mix_pre[l]), sh1, sc1) @ w_in[l]).astype(jnp.float32)
        u_ctx = (_modulate(_rmsnorm(ctx, norm_mix_pre[l]), csh1, csc1) @ w_in[l]).astype(jnp.float32)
        ua_c, ub_c, uc_c = _split(u_ctx, (RET_IN, GLA_IN, RWKV_IN))
        ua_l, ub_l, uc_l = _split(u_lat, (RET_IN, GLA_IN, RWKV_IN))
        ya_c, ya_l = _retention_mixer(ua_c, ua_l, row, col, ret_norm[l], ctx_out)
        yb_c, yb_l = _gla_mixer(ub_c, ub_l, gla_wa2_f[l], gla_ba_f[l], gla_wa2_b[l], gla_ba_b[l],
                                gla_norm[l], ctx_out)
        yc_c, yc_l = _rwkv_mixer(uc_c, uc_l, rw_conv[l], rw_w0_f[l], rw_w2_f[l], rw_w0_b[l], rw_w2_b[l],
                                 rw_a0[l], rw_a2[l], rw_g2[l], rw_k_k[l], rw_k_a[l], rw_r_k[l],
                                 rw_ln_w[l], rw_ln_b[l], ctx_out)
        y_lat = jnp.concatenate([ya_l, yb_l, yc_l], axis=-1).astype(x.dtype) @ w_out[l]
        x = x + gt1 * _rmsnorm(y_lat, norm_mix_post[l])

        f_lat = _swiglu(_modulate(_rmsnorm(x, norm_ffn_pre[l]), sh2, sc2), w_ffn_gate[l], w_ffn_up[l], w_ffn_down[l])
        x = x + gt2 * _rmsnorm(f_lat, norm_ffn_post[l])

        if ctx_out:
            y_ctx = jnp.concatenate([ya_c, yb_c, yc_c], axis=-1).astype(ctx.dtype) @ w_out[l]
            ctx = ctx + cgt1 * _rmsnorm(y_ctx, norm_mix_post[l])
            f_ctx = _swiglu(_modulate(_rmsnorm(ctx, norm_ffn_pre[l]), csh2, csc2), w_ffn_gate[l], w_ffn_up[l], w_ffn_down[l])
            ctx = ctx + cgt2 * _rmsnorm(f_ctx, norm_ffn_post[l])
    return x
```

```cpp
#include <hip/hip_runtime.h>
#include <hip/hip_cooperative_groups.h>
#include <cstdio>
namespace cg = cooperative_groups;
namespace pg8 {
#define PG8_LAS __attribute__((address_space(3)))
typedef unsigned short bf16_t;
typedef short bf16x8 __attribute__((ext_vector_type(8)));
typedef float f32x4 __attribute__((ext_vector_type(4)));
typedef unsigned u32x4 __attribute__((ext_vector_type(4)));
constexpr int BM = 256, BK = 64, HALF = 128, HTB = HALF * BK * 2  , STAGE_BYTES = 8 * HTB, NXCD = 8, WGM = 8;

__host__ __device__ __forceinline__ int lds_byte(int r, int c) { const int st = (r >> 4) * 2 + (c >> 5), rr = r & 15, cc = c & 31, ob = rr * 64 + cc * 2; return st * 1024 + (ob ^ (((ob >> 9) & 1) << 5)); }
__host__ __device__ __forceinline__ void stage_rc(int b, int& R, int& C) { const int st = b / 1024, sb = b % 1024, swz = sb ^ (((sb >> 9) & 1) << 5); R = (st >> 1) * 16 + swz / 64; C = (st & 1) * 32 + (swz % 64) / 2; }
__host__ __device__ __forceinline__ int perm32(int rho) { const int n = rho >> 4, i = rho & 15; return 8 * (i >> 2) + 4 * n + (i & 3); }

struct Unit { int pm, pn; };
struct Gemm { const bf16_t* A; const bf16_t* Bt; int M, N, K; };

struct StaticOrder {
    int nM, nN, nwg, G, c;
    __host__ __device__ void init(int M, int N, int G_, int c_) { nM = M / BM; nN = N / BM; nwg = nM * nN; G = G_; c = c_; }
    __host__ __device__ bool next(int i, Unit& u) const {
        const long L = (long)i * G + c; if (L >= nwg) return false;
        int wgid = (int)L; { const int q = nwg / NXCD, r = nwg % NXCD, xcd = wgid % NXCD, off = wgid / NXCD; wgid = (xcd < r ? xcd * (q + 1) : r * (q + 1) + (xcd - r) * q) + off; }
        const int nig = WGM * nN, gid = wgid / nig, fm = gid * WGM, gsz = (nM - fm) < WGM ? (nM - fm) : WGM;
        u.pm = fm + ((wgid % nig) % gsz); u.pn = (wgid % nig) / gsz; return true;
    }
    __device__ __forceinline__ void a_ready(const Unit&) const {}
    __device__ __forceinline__ void done(const Unit&) const {}
};
__device__ __forceinline__ unsigned cvt_pk_bf16(float lo, float hi) { unsigned r; asm volatile("v_cvt_pk_bf16_f32 %0, %1, %2" : "=v"(r) : "v"(lo), "v"(hi)); return r; }
typedef float f32x2 __attribute__((ext_vector_type(2)));
__device__ __forceinline__ f32x2 gelu_pk(f32x2 v) {
    const f32x2 av = __builtin_elementwise_abs(v), d = av * 0.2316418882f + 1.0f;
    f32x2 t; t.x = __builtin_amdgcn_rcpf(d.x); t.y = __builtin_amdgcn_rcpf(d.y);
    f32x2 q = t * 0.5307027145f + (-0.7265760135f); q = q * t + 0.7107068705f; q = q * t + (-0.142248368f); q = q * t + 0.127414796f; q = q * t;
    const f32x2 s = (v * v) * (-0.72134752044f);
    f32x2 e; e.x = __builtin_amdgcn_exp2f(s.x); e.y = __builtin_amdgcn_exp2f(s.y);
    const f32x2 m = v * (q * e), r = v - m;
    f32x2 o; o.x = v.x < 0.f ? m.x : r.x; o.y = v.y < 0.f ? m.y : r.y; return o;
}

struct EpiF32 {
    static constexpr bool PERM = false, AFTER_DRAIN = false;
    float* C; int ldc; const float* bias;
    __device__ __forceinline__ void operator()(const f32x4 (&acc)[2][2][4][2], const Unit& u, int wr, int wc, int fr, int fq) const {
        const int row0 = u.pm * BM + wr * 64 + fr, col0 = u.pn * BM + wc * 32 + 4 * fq;
        f32x4 bv[2][2];
#pragma unroll
        for (int bj = 0; bj < 2; ++bj)
#pragma unroll
            for (int n = 0; n < 2; ++n) bv[bj][n] = bias ? *(const f32x4*)(bias + col0 + bj * HALF + n * 16) : (f32x4){0.f, 0.f, 0.f, 0.f};
#pragma unroll
        for (int ai = 0; ai < 2; ++ai)
#pragma unroll
            for (int m = 0; m < 4; ++m) { float* rowp = C + (size_t)(row0 + ai * HALF + m * 16) * ldc + col0;
#pragma unroll
                for (int bj = 0; bj < 2; ++bj)
#pragma unroll
                    for (int n = 0; n < 2; ++n) *(f32x4*)(rowp + bj * HALF + n * 16) = acc[ai][bj][m][n] + bv[bj][n]; }
    }
};
template <int ACT  > struct EpiBf16 {
    static constexpr bool PERM = true, AFTER_DRAIN = false;
    bf16_t* O; int ldc; const float* bias; int split_cols; size_t split_stride;
    __device__ __forceinline__ void operator()(const f32x4 (&acc)[2][2][4][2], const Unit& u, int wr, int wc, int fr, int fq) const {
        const int row0 = u.pm * BM + wr * 64 + fr; int colt = u.pn * BM; bf16_t* base = O;
        if (split_cols) { const int t = colt / split_cols; base += (size_t)t * split_stride; colt -= t * split_cols; }
        const int col0 = colt + wc * 32 + 8 * fq, bcol0 = u.pn * BM + wc * 32 + 8 * fq;
        f32x4 bv[2][2];
#pragma unroll
        for (int bj = 0; bj < 2; ++bj)
#pragma unroll
            for (int n = 0; n < 2; ++n) bv[bj][n] = bias ? *(const f32x4*)(bias + bcol0 + bj * HALF + 4 * n) : (f32x4){0.f, 0.f, 0.f, 0.f};
#pragma unroll
        for (int ai = 0; ai < 2; ++ai)
#pragma unroll
            for (int m = 0; m < 4; ++m) { bf16_t* rowp = base + (size_t)(row0 + ai * HALF + m * 16) * ldc + col0;
#pragma unroll
                for (int bj = 0; bj < 2; ++bj) { f32x4 v0 = acc[ai][bj][m][0] + bv[bj][0], v1 = acc[ai][bj][m][1] + bv[bj][1];
                    if (ACT == 1) { f32x2 a = gelu_pk((f32x2){v0[0], v0[1]}), b = gelu_pk((f32x2){v0[2], v0[3]}), c = gelu_pk((f32x2){v1[0], v1[1]}), d = gelu_pk((f32x2){v1[2], v1[3]});
                        v0 = (f32x4){a.x, a.y, b.x, b.y}; v1 = (f32x4){c.x, c.y, d.x, d.y}; }
                    if (ACT == 2) {
#pragma unroll
                        for (int j = 0; j < 4; ++j) { v0[j] = 0.5f * v0[j] * (1.0f + erff(v0[j] * 0.70710678f)); v1[j] = 0.5f * v1[j] * (1.0f + erff(v1[j] * 0.70710678f)); } }
                    u32x4 w; w.x = cvt_pk_bf16(v0[0], v0[1]); w.y = cvt_pk_bf16(v0[2], v0[3]); w.z = cvt_pk_bf16(v1[0], v1[1]); w.w = cvt_pk_bf16(v1[2], v1[3]);
                    *(u32x4*)(rowp + bj * HALF) = w; } }
    }
};
template <class Epi, class Sched, bool STAMP = false>
__device__ __forceinline__ void gemm_phase(PG8_LAS unsigned char* lds, const Gemm g, const Sched& S, const Epi& E, unsigned long long* stamps) {
    const int tid = threadIdx.x, wid = __builtin_amdgcn_readfirstlane(tid >> 6), lane = tid & 63, wr = wid >> 2, wc = wid & 3, fr = lane & 15, fq = lane >> 4;
    const int K = g.K, nt = K / BK;
    int ts_lo = 0, ts_hi = 0, nts = 0; const unsigned long long rt_entry = STAMP ? (unsigned long long)wall_clock64() : 0ull;
#define PG8_STAMP() do { if (STAMP && wid == 0 && nts < 64) { const unsigned long long _c = (unsigned long long)clock64(); \
        ts_lo = (lane == nts) ? (int)(unsigned)_c : ts_lo; ts_hi = (lane == nts) ? (int)(unsigned)(_c >> 32) : ts_hi; ++nts; } } while (0)
    PG8_STAMP();
    unsigned voffA[2], voffB[2];
#pragma unroll
    for (int i = 0; i < 2; ++i) { int R, C; stage_rc(tid * 16 + i * 8192, R, C); const int Rb = Epi::PERM ? ((R & ~31) + perm32(R & 31)) : R;
        voffA[i] = (unsigned)(R * K + C) * 2u; voffB[i] = (unsigned)(Rb * K + C) * 2u; }
    const size_t kstep = (size_t)(BK * 2);
    const size_t hstep = (size_t)HALF * K * 2;
    const size_t tstep = 2 * hstep;
    const unsigned ldsw = (unsigned)wid * 1024u;
    const int aoff = lds_byte(wr * 64 + fr, fq * 8), boff = lds_byte(wc * 32 + fr, fq * 8);
#define PG8_SA(b, h) (((b) * 2 + (h)) * HTB)
#define PG8_SB(b, h) ((4 + (b) * 2 + (h)) * HTB)
#define PG8_STAGE(bufoff, gbase, voff) do { _Pragma("unroll") for (int _i = 0; _i < 2; ++_i) \
        __builtin_amdgcn_global_load_lds((const unsigned*)((const char*)(gbase) + (voff)[_i]), (PG8_LAS unsigned*)(lds + (bufoff) + ldsw + _i * 8192), 16, 0, 0); } while (0)
#define PG8_LDA(dst, b, h) do { _Pragma("unroll") for (int m = 0; m < 4; ++m) _Pragma("unroll") for (int k = 0; k < 2; ++k) dst[m][k] = *(const PG8_LAS bf16x8*)(lds + PG8_SA(b, h) + aoff + m * 2048 + k * 1024); } while (0)
#define PG8_LDB(dst, b, h) do { _Pragma("unroll") for (int n = 0; n < 2; ++n) _Pragma("unroll") for (int k = 0; k < 2; ++k) dst[n][k] = *(const PG8_LAS bf16x8*)(lds + PG8_SB(b, h) + boff + n * 2048 + k * 1024); } while (0)
#define PG8_MMA(ai, bj, At, Bt) do { __builtin_amdgcn_s_setprio(1); _Pragma("unroll") for (int m = 0; m < 4; ++m) _Pragma("unroll") for (int n = 0; n < 2; ++n) _Pragma("unroll") for (int k = 0; k < 2; ++k) \
        acc[ai][bj][m][n] = __builtin_amdgcn_mfma_f32_16x16x32_bf16(Bt[n][k], At[m][k], acc[ai][bj][m][n], 0, 0, 0); __builtin_amdgcn_s_setprio(0); } while (0)
#define PG8_WAIT_V(n) asm volatile("s_waitcnt vmcnt(" #n ")" ::: "memory")
#define PG8_WAIT_L(n) asm volatile("s_waitcnt lgkmcnt(" #n ")" ::: "memory")
#define PG8_BAR __builtin_amdgcn_s_barrier()
#define PG8_SCHED __builtin_amdgcn_sched_barrier(0)
    Unit cur, nxt; int ui = 0;
    if (!S.next(0, cur)) return;
    f32x4 acc[2][2][4][2];
#pragma unroll
    for (int a = 0; a < 2; ++a)
#pragma unroll
        for (int b = 0; b < 2; ++b)
#pragma unroll
            for (int m = 0; m < 4; ++m)
#pragma unroll
                for (int n = 0; n < 2; ++n) acc[a][b][m][n] = (f32x4){0.f, 0.f, 0.f, 0.f};
    bf16x8 At[4][2], B0[2][2], B1[2][2];
    const char* cA = (const char*)g.A + (size_t)cur.pm * tstep; const char* cB = (const char*)g.Bt + (size_t)cur.pn * tstep;
    S.a_ready(cur);
    PG8_STAGE(PG8_SB(0, 0), cB, voffB); PG8_STAGE(PG8_SA(0, 0), cA, voffA); PG8_STAGE(PG8_SB(0, 1), cB + hstep, voffB); PG8_STAGE(PG8_SA(0, 1), cA + hstep, voffA);
    if (wr == 1) PG8_BAR;
    PG8_WAIT_V(4); PG8_BAR;
    PG8_STAGE(PG8_SB(1, 0), cB + kstep, voffB); PG8_STAGE(PG8_SA(1, 0), cA + kstep, voffA); PG8_STAGE(PG8_SB(1, 1), cB + hstep + kstep, voffB);
    PG8_WAIT_V(6); PG8_BAR;
    PG8_STAMP();
    for (;;) {
        const bool has_next = S.next(ui + 1, nxt);
        const char* nA = has_next ? (const char*)g.A + (size_t)nxt.pm * tstep : cA; const char* nB = has_next ? (const char*)g.Bt + (size_t)nxt.pn * tstep : cB;
        for (int t = 0; t < nt; t += 2) {
            const bool last = (t == nt - 2);
            const char* a1 = cA + (size_t)(t + 1) * kstep;
            const char* a2 = last ? nA : cA + (size_t)(t + 2) * kstep; const char* b2 = last ? nB : cB + (size_t)(t + 2) * kstep;
            const char* a3 = a2 + kstep; const char* b3 = b2 + kstep;
            if (last && has_next) S.a_ready(nxt);
            PG8_LDB(B0, 0, 0); PG8_SCHED; PG8_LDA(At, 0, 0); PG8_STAGE(PG8_SA(1, 1), a1 + hstep, voffA);
            PG8_WAIT_L(8); PG8_BAR; PG8_WAIT_L(0); PG8_MMA(0, 0, At, B0); PG8_BAR; PG8_SCHED;
            PG8_LDB(B1, 0, 1); PG8_STAGE(PG8_SB(0, 0), b2, voffB);
            PG8_BAR; PG8_WAIT_L(0); PG8_MMA(0, 1, At, B1); PG8_BAR;
            PG8_LDA(At, 0, 1); PG8_STAGE(PG8_SA(0, 0), a2, voffA);
            PG8_BAR; PG8_WAIT_L(0); PG8_MMA(1, 0, At, B0); PG8_BAR; PG8_SCHED;
            PG8_STAGE(PG8_SB(0, 1), b2 + hstep, voffB);
            PG8_WAIT_V(6); PG8_BAR; PG8_MMA(1, 1, At, B1); PG8_BAR;
            PG8_LDB(B0, 1, 0); PG8_SCHED; PG8_LDA(At, 1, 0); PG8_STAGE(PG8_SA(0, 1), a2 + hstep, voffA);
            PG8_WAIT_L(8); PG8_BAR; PG8_WAIT_L(0); PG8_MMA(0, 0, At, B0); PG8_BAR; PG8_SCHED;
            PG8_LDB(B1, 1, 1); PG8_STAGE(PG8_SB(1, 0), b3, voffB);
            PG8_BAR; PG8_WAIT_L(0); PG8_MMA(0, 1, At, B1); PG8_BAR;
            PG8_LDA(At, 1, 1); PG8_STAGE(PG8_SA(1, 0), a3, voffA);
            PG8_BAR; PG8_WAIT_L(0); PG8_MMA(1, 0, At, B0); PG8_BAR; PG8_SCHED;
            PG8_STAGE(PG8_SB(1, 1), b3 + hstep, voffB);
            PG8_WAIT_V(6); PG8_BAR; PG8_MMA(1, 1, At, B1); PG8_BAR;
        }
        PG8_STAMP();
        if constexpr (!Epi::AFTER_DRAIN) { E(acc, cur, wr, wc, fr, fq); S.done(cur); }
        PG8_STAMP();
        if (!has_next) break;
#pragma unroll
        for (int a = 0; a < 2; ++a)
#pragma unroll
            for (int b = 0; b < 2; ++b)
#pragma unroll
                for (int m = 0; m < 4; ++m)
#pragma unroll
                    for (int n = 0; n < 2; ++n) acc[a][b][m][n] = (f32x4){0.f, 0.f, 0.f, 0.f};
        cur = nxt; cA = nA; cB = nB; ++ui;
    }
    PG8_WAIT_V(0);
    if (wr == 0) PG8_BAR;
    PG8_BAR;
    if constexpr (Epi::AFTER_DRAIN) { E.fused(acc, cur, wr, wc, fr, fq, lds, wid, lane); S.done(cur); }
    PG8_STAMP();
    if (STAMP && wid == 0) { stamps[lane] = lane < nts ? (((unsigned long long)(unsigned)ts_hi << 32) | (unsigned)ts_lo) : 0ull;
        if (lane == 62) stamps[62] = rt_entry; if (lane == 63) stamps[63] = (unsigned long long)wall_clock64(); }
#undef PG8_STAMP
#undef PG8_SA
#undef PG8_SB
#undef PG8_STAGE
#undef PG8_LDA
#undef PG8_LDB
#undef PG8_MMA
#undef PG8_WAIT_V
#undef PG8_WAIT_L
#undef PG8_BAR
#undef PG8_SCHED
}
}
namespace pg8 {
struct EpiSwiGLU {
    static constexpr bool PERM = true, AFTER_DRAIN = false;
    bf16_t* H; int ldh;
    __device__ __forceinline__ void operator()(const f32x4 (&acc)[2][2][4][2], const Unit& u, int wr, int wc, int fr, int fq) const {
        const int row0 = u.pm * BM + wr * 64 + fr, col0 = u.pn * HALF + wc * 32 + 8 * fq;
#pragma unroll
        for (int ai = 0; ai < 2; ++ai)
#pragma unroll
            for (int m = 0; m < 4; ++m) { bf16_t* rowp = H + (size_t)(row0 + ai * HALF + m * 16) * ldh + col0;
                float hv[8];
#pragma unroll
                for (int n = 0; n < 2; ++n)
#pragma unroll
                    for (int j = 0; j < 4; ++j) { const float g = acc[ai][0][m][n][j], up = acc[ai][1][m][n][j]; hv[n * 4 + j] = g * up * __builtin_amdgcn_rcpf(1.0f + __expf(-g)); }
                u32x4 w; w.x = cvt_pk_bf16(hv[0], hv[1]); w.y = cvt_pk_bf16(hv[2], hv[3]); w.z = cvt_pk_bf16(hv[4], hv[5]); w.w = cvt_pk_bf16(hv[6], hv[7]);
                *(u32x4*)rowp = w; }
    }
};
}

#define LAS __attribute__((address_space(3)))
typedef unsigned short bf16_t;
typedef short bf16x8 __attribute__((ext_vector_type(8)));
typedef float f32x4 __attribute__((ext_vector_type(4)));
typedef unsigned u32x4 __attribute__((ext_vector_type(4)));
typedef unsigned u32x2 __attribute__((ext_vector_type(2)));

constexpr int D = 1024, MLAT = 16384, MCTX = 512, MALL = 16896, SEQ = 8192, CTXL = 256, NCH = 132;
constexpr int INW = 3680, NU = 3840, FF = 2816, NGU = 5632;
constexpr size_t WS_MOD = 0;
constexpr size_t WS_CTX = 262144;
constexpr size_t WS_WIN = WS_CTX + (size_t)MCTX * D * 4;
constexpr size_t WS_WOUT = WS_WIN + (size_t)NU * D * 2;
constexpr size_t WS_WGU = WS_WOUT + (size_t)D * D * 2;
constexpr size_t WS_WDN = WS_WGU + (size_t)NGU * D * 2;
constexpr size_t WS_U = WS_WDN + (size_t)D * FF * 2;
constexpr size_t U_BYTES = (size_t)MALL * NU * 2;
constexpr size_t H_BYTES = (size_t)MALL * FF * 2;
constexpr size_t C_BYTES = (size_t)MALL * D * 4;
constexpr size_t WS_C2 = WS_U + H_BYTES;
constexpr size_t WS_ORW = WS_U + U_BYTES;
constexpr size_t WS_Y = WS_C2 + C_BYTES;
constexpr size_t WS_SRET = WS_Y + (size_t)MALL * D * 2;
constexpr size_t WS_SGLA = WS_SRET + (size_t)16 * NCH * 4096 * 2;
constexpr size_t WS_DEC = WS_SGLA + (size_t)16 * NCH * 4608 * 2;
constexpr size_t WS_END = WS_DEC + (size_t)32 * NCH * 64 * 4;
static_assert(WS_ORW + (size_t)MALL * 384 * 4 <= WS_Y, "orw overlaps y");
static_assert(WS_END <= (size_t)268435456, "workspace too large");
constexpr int LDS_BYTES = 147456;
#ifndef PHM
#define PHM 0xFFFF
#endif

struct Params { const float* in[34]; float* out; unsigned char* ws; };

__device__ __forceinline__ int vopaque(int v) { asm volatile("" : "+v"(v)); return v; }
__device__ __forceinline__ unsigned pk2(float lo, float hi) { unsigned r; asm("v_cvt_pk_bf16_f32 %0, %1, %2" : "=v"(r) : "v"(lo), "v"(hi)); return r; }
__device__ __forceinline__ bf16_t f2bf(float f) { return (bf16_t)(pk2(f, 0.f) & 0xffffu); }
__device__ __forceinline__ float bf2f(bf16_t b) { return __uint_as_float(((unsigned)b) << 16); }
__device__ __forceinline__ float wave_sum(float v) {
#pragma unroll
    for (int o = 1; o < 64; o <<= 1) v += __shfl_xor(v, o);
    return v; }
__device__ __forceinline__ float sigmoidf_(float x) { return 1.f / (1.f + __expf(-x)); }
__device__ __forceinline__ float siluf_(float x) { return x / (1.f + __expf(-x)); }
__device__ __forceinline__ int chunk_row0(int b, int cs) { return cs < 4 ? MLAT + b * CTXL + cs * 64 : b * SEQ + (cs - 4) * 64; }

template <int K> __device__ __forceinline__ f32x4 mma_tile(const LAS bf16_t* A, int lda, const LAS bf16_t* Bt, int ldb, f32x4 acc, int r, int q) {
#pragma unroll
    for (int k0 = 0; k0 < K; k0 += 32) {
        const bf16x8 a = *(const LAS bf16x8*)(A + r * lda + k0 + q * 8);
        const bf16x8 b = *(const LAS bf16x8*)(Bt + r * ldb + k0 + q * 8);
        acc = __builtin_amdgcn_mfma_f32_16x16x32_bf16(a, b, acc, 0, 0, 0);
    }
    return acc;
}

__device__ __forceinline__ void mod_phase(const Params& p, LAS unsigned char* lds, int bid, int nb) {
    LAS float* sc = (LAS float*)lds;
    LAS float* red = sc + 3072;
    const int tid = vopaque((int)threadIdx.x);
    for (int i = tid; i < 3072; i += 512) { const int s = i >> 10, k = i & 1023; const float v = s < 2 ? p.in[1][s * 1024 + k] : p.in[3][k]; sc[i] = siluf_(v); }
    __syncthreads();
    const int col = tid & 63, kg = tid >> 6;
    float* modo = (float*)(p.ws + WS_MOD);
    for (int it = bid; it < 192; it += nb) {
        const int l = it / 96, c0 = (it % 96) * 64;
        const float* W = p.in[4] + (size_t)l * D * 6144 + c0 + col;
        float a0 = 0.f, a1 = 0.f, a2 = 0.f;
#pragma unroll 8
        for (int k = kg * 128; k < kg * 128 + 128; ++k) { const float w = W[(size_t)k * 6144]; a0 += sc[k] * w; a1 += sc[1024 + k] * w; a2 += sc[2048 + k] * w; }
        red[(kg * 3 + 0) * 64 + col] = a0; red[(kg * 3 + 1) * 64 + col] = a1; red[(kg * 3 + 2) * 64 + col] = a2;
        __syncthreads();
        if (tid < 192) { const int s = tid >> 6; float t = 0.f;
#pragma unroll
            for (int g = 0; g < 8; ++g) t += red[(g * 3 + s) * 64 + col];
            modo[(l * 3 + s) * 6144 + c0 + col] = t + p.in[5][l * 6144 + c0 + col]; }
        __syncthreads();
    }
}

__device__ __forceinline__ void wt_item(const float* src, int ldw, bool zero, bf16_t* dst, int K, LAS float* scr, int lane) {
#pragma unroll 8
    for (int i = 0; i < 32; ++i) { const int kk = 2 * i + (lane >> 5); scr[kk * 33 + (lane & 31)] = zero ? 0.f : src[(size_t)kk * ldw + (lane & 31)]; }
    asm volatile("s_waitcnt lgkmcnt(0)" ::: "memory");
    const int c = lane & 7;
#pragma unroll
    for (int j = 0; j < 4; ++j) { const int n = (lane >> 3) + 8 * j; const LAS float* s = scr + (8 * c) * 33 + n;
        u32x4 o; o.x = pk2(s[0], s[33]); o.y = pk2(s[66], s[99]); o.z = pk2(s[132], s[165]); o.w = pk2(s[198], s[231]);
        *(u32x4*)(dst + (size_t)n * K + 8 * c) = o; }
    asm volatile("s_waitcnt lgkmcnt(0)" ::: "memory");
}
__device__ __forceinline__ void wconv_items(const Params& p, int l, int set, LAS unsigned char* lds, int bid, int G) {
    unsigned char* ws = p.ws; const int tid = vopaque((int)threadIdx.x), lane = tid & 63, wv = tid >> 6, gw = bid * 8 + wv, ngw = G * 8; LAS float* scr = (LAS float*)(lds + wv * 8448);
    if (set == 0) {
        const float* W = p.in[10] + (size_t)l * D * INW;
        for (int it = gw; it < 120 * 16; it += ngw) { const int kb = it / 120, nb = it % 120;
            wt_item(W + (size_t)(kb * 64) * INW + nb * 32, INW, nb * 32 >= INW, (bf16_t*)(ws + WS_WIN) + (size_t)(nb * 32) * D + kb * 64, D, scr, lane); }
    } else {
        for (int it = gw; it < 512 + 2816 + 1408; it += ngw) {
            int r = it;
            if (r < 512) { const int kb = r / 32, nb = r % 32;
                wt_item(p.in[30] + (size_t)l * D * D + (size_t)(kb * 64) * D + nb * 32, D, false, (bf16_t*)(ws + WS_WOUT) + (size_t)(nb * 32) * D + kb * 64, D, scr, lane); continue; }
            r -= 512;
            if (r < 2816) { const int kb = r / 176, nb = r % 176; const int n0 = nb * 32, tile = n0 >> 8, within = n0 & 255, hid = tile * 128 + (within & 127);
                const float* W = (within < 128 ? p.in[31] : p.in[32]) + (size_t)l * D * FF;
                wt_item(W + (size_t)(kb * 64) * FF + hid, FF, false, (bf16_t*)(ws + WS_WGU) + (size_t)n0 * D + kb * 64, D, scr, lane); continue; }
            r -= 2816;
            { const int kb = r / 32, nb = r % 32;
                wt_item(p.in[33] + (size_t)l * FF * D + (size_t)(kb * 64) * D + nb * 32, D, false, (bf16_t*)(ws + WS_WDN) + (size_t)(nb * 32) * FF + kb * 64, FF, scr, lane); }
        }
    }
}

__device__ __forceinline__ void row_phase(const float* res_lat, const float* res_ctx, const float* Cm, const float* gpost, const float* modg, int gate_off,
                                          float* dst_lat, float* dst_ctx, const float* gpre, const float* modn, int sh_off, int sc_off, bf16_t* xn, int M, int bid, int G) {
    const int tid = vopaque((int)threadIdx.x), lane = tid & 63, gw = bid * 8 + (tid >> 6), ngw = G * 8;
    for (int m = gw; m < M; m += ngw) {
        const bool isctx = m >= MLAT; const int ms = isctx ? 2 : (m >> 13);
        const float* rrow = isctx ? res_ctx + (size_t)(m - MLAT) * D : res_lat + (size_t)m * D;
        f32x4 v[4];
#pragma unroll
        for (int j = 0; j < 4; ++j) v[j] = *(const f32x4*)(rrow + j * 256 + lane * 4);
        if (Cm) {
            f32x4 c[4]; float ss = 0.f;
#pragma unroll
            for (int j = 0; j < 4; ++j) { c[j] = *(const f32x4*)(Cm + (size_t)m * D + j * 256 + lane * 4); ss += c[j][0] * c[j][0] + c[j][1] * c[j][1] + c[j][2] * c[j][2] + c[j][3] * c[j][3]; }
            ss = wave_sum(ss); const float rstd = rsqrtf(ss * (1.f / 1024.f) + 1e-6f);
#pragma unroll
            for (int j = 0; j < 4; ++j) { const int col = j * 256 + lane * 4; const f32x4 gp = *(const f32x4*)(gpost + col); const f32x4 gt = *(const f32x4*)(modg + ms * 6144 + gate_off + col);
                v[j] = v[j] + gt * (c[j] * rstd * gp); }
        }
        if (dst_lat) { float* drow = isctx ? dst_ctx + (size_t)(m - MLAT) * D : dst_lat + (size_t)m * D;
#pragma unroll
            for (int j = 0; j < 4; ++j) *(f32x4*)(drow + j * 256 + lane * 4) = v[j]; }
        if (xn) {
            float ss = 0.f;
#pragma unroll
            for (int j = 0; j < 4; ++j) ss += v[j][0] * v[j][0] + v[j][1] * v[j][1] + v[j][2] * v[j][2] + v[j][3] * v[j][3];
            ss = wave_sum(ss); const float rstd = rsqrtf(ss * (1.f / 1024.f) + 1e-6f);
#pragma unroll
            for (int j = 0; j < 4; ++j) { const int col = j * 256 + lane * 4; const f32x4 gp = *(const f32x4*)(gpre + col);
                const f32x4 sh = *(const f32x4*)(modn + ms * 6144 + sh_off + col), sc = *(const f32x4*)(modn + ms * 6144 + sc_off + col);
                const f32x4 y = (v[j] * rstd * gp) * (sc + 1.f) + sh;
                u32x2 o; o.x = pk2(y[0], y[1]); o.y = pk2(y[2], y[3]); *(u32x2*)(xn + (size_t)m * D + col) = o; }
        }
    }
}

constexpr int LP = 72;
__device__ __forceinline__ float logsig_(float z) { return fminf(z, 0.f) - __logf(1.f + __expf(-fabsf(z))); }
__device__ __forceinline__ void la_item(const Params& p, int l, int idx, int pass, bool last, LAS unsigned char* lds) {
    const int tid = vopaque((int)threadIdx.x), lane = tid & 63, w = tid >> 6, r = lane & 15, q = lane >> 4;
    const int kind = idx / 1056, rem = idx % 1056, b = rem / 528, rem2 = rem % 528, cs = rem2 >> 2, h = rem2 & 3;
    if (pass == 3 && last && cs < 4) return;
    const int DK = kind ? 48 : 64, DV = kind ? 96 : 64;
    const int qoff = kind ? 1024 + 48 * h : 64 * h, koff = kind ? 1216 + 48 * h : 256 + 64 * h, voff = kind ? 1408 + 96 * h : 512 + 64 * h, goff = kind ? 1792 + 96 * h : 768 + 64 * h;
    const int ycol = kind ? 256 + 96 * h : 64 * h;
    const int row0 = chunk_row0(b, cs);
    const int chain = ((kind * 2 + b) * 4 + h) * 2;
    const bf16_t* U = (const bf16_t*)(p.ws + WS_U);
    bf16_t* Y = (bf16_t*)(p.ws + WS_Y);
    bf16_t* Sf = kind ? (bf16_t*)(p.ws + WS_SGLA) + ((size_t)(chain - 16) * NCH + cs) * 4608 : (bf16_t*)(p.ws + WS_SRET) + ((size_t)chain * NCH + cs) * 4096;
    bf16_t* Sb = Sf + (size_t)NCH * (kind ? 4608 : 4096);
    float* dec = (float*)(p.ws + WS_DEC) + ((size_t)chain * NCH + cs) * 64;
    LAS float* cumf = (LAS float*)lds; LAS float* cumb = cumf + 4096;
    LAS bf16_t* QF = (LAS bf16_t*)(lds + 32768); LAS bf16_t* QB = QF + 64 * LP; LAS bf16_t* KF = QB + 64 * LP; LAS bf16_t* KB = KF + 64 * LP;
    LAS bf16_t* VT = KB + 64 * LP; LAS bf16_t* PF = VT + 96 * LP; LAS bf16_t* PB = PF + 64 * LP; LAS bf16_t* STF = PB + 64 * LP; LAS bf16_t* STB = STF + 96 * LP;
    LAS float* red = (LAS float*)(STB + 96 * LP);
    if (kind == 0) {
        const float lgf = logf(1.f - exp2f(-5.f - (float)h)), lgb = logf(1.f - exp2f(-5.f - (float)(3 - h)));
        for (int e = tid; e < 4096; e += 512) { const int i = e >> 6; cumf[e] = (float)(i + 1) * lgf; cumb[e] = (float)(64 - i) * lgb; }
    } else {
        const float* wa2f = p.in[12] + l * 16 * 192 + h * 48; const float* baf = p.in[13] + l * 192 + h * 48;
        const float* wa2b = p.in[14] + l * 16 * 192 + h * 48; const float* bab = p.in[15] + l * 192 + h * 48;
        for (int e = tid; e < 4096; e += 512) { const int i = e >> 6, d = e & 63; float zf = 0.f, zb = 0.f;
            if (d < 48) { zf = baf[d]; zb = bab[d]; const bf16_t* lr = U + (size_t)(row0 + i) * NU + 2176;
#pragma unroll
                for (int rr = 0; rr < 16; ++rr) { zf += bf2f(lr[rr]) * wa2f[rr * 192 + d]; zb += bf2f(lr[16 + rr]) * wa2b[rr * 192 + d]; }
                zf = logsig_(zf) * 0.0625f; zb = logsig_(zb) * 0.0625f; }
            cumf[e] = zf; cumb[e] = zb; }
        __syncthreads();
        if (tid < 64) { float run = 0.f; for (int i = 0; i < 64; ++i) { run += cumf[i * 64 + tid]; cumf[i * 64 + tid] = run; } }
        else if (tid < 128) { const int d = tid - 64; float run = 0.f; for (int i = 63; i >= 0; --i) { run += cumb[i * 64 + d]; cumb[i * 64 + d] = run; } }
    }
    __syncthreads();
    const bool rope = (kind == 0) && (cs >= 4);
    const float qs = kind ? 0.14433756729740643f : 1.f, ks = kind ? 1.f : 0.125f;
    for (int e = tid; e < 2048; e += 512) {
        const int i = e >> 5, pp = e & 31, d1 = pp < 16 ? pp : pp + 16, d2 = d1 + 16;
        const bf16_t* ur = U + (size_t)(row0 + i) * NU;
        float q1 = d1 < DK ? bf2f(ur[qoff + d1]) : 0.f, q2 = d2 < DK ? bf2f(ur[qoff + d2]) : 0.f;
        float k1 = d1 < DK ? bf2f(ur[koff + d1]) : 0.f, k2 = d2 < DK ? bf2f(ur[koff + d2]) : 0.f;
        if (rope) { const float pos = pp < 16 ? (float)(cs - 4) : (float)i; const float ang = pos * exp2f(-(float)(pp & 15) * 0.8304820237218406f);
            const float sn = __sinf(ang), cn = __cosf(ang);
            const float a = q1 * cn - q2 * sn, bq = q1 * sn + q2 * cn, c = k1 * cn - k2 * sn, dk_ = k1 * sn + k2 * cn; q1 = a; q2 = bq; k1 = c; k2 = dk_; }
        q1 *= qs; q2 *= qs; k1 *= ks; k2 *= ks;
        const float cf1 = cumf[i * 64 + d1], cf2 = cumf[i * 64 + d2], cb1 = cumb[i * 64 + d1], cb2 = cumb[i * 64 + d2];
        if (pass == 3) {
            QF[i * LP + d1] = f2bf(q1 * __expf(cf1)); QF[i * LP + d2] = f2bf(q2 * __expf(cf2));
            QB[i * LP + d1] = f2bf(q1 * __expf(cb1)); QB[i * LP + d2] = f2bf(q2 * __expf(cb2));
            KF[i * LP + d1] = f2bf(k1 * __expf(-cf1)); KF[i * LP + d2] = f2bf(k2 * __expf(-cf2));
            KB[i * LP + d1] = f2bf(k1 * __expf(-cb1)); KB[i * LP + d2] = f2bf(k2 * __expf(-cb2));
        } else {
            const float ef1 = cumf[63 * 64 + d1], ef2 = cumf[63 * 64 + d2], eb1 = cumb[d1], eb2 = cumb[d2];
            KF[d1 * LP + i] = f2bf(k1 * __expf(ef1 - cf1)); KF[d2 * LP + i] = f2bf(k2 * __expf(ef2 - cf2));
            KB[d1 * LP + i] = f2bf(k1 * __expf(eb1 - cb1)); KB[d2 * LP + i] = f2bf(k2 * __expf(eb2 - cb2));
        }
    }
    { const int nvb = DV >> 3;
      for (int e = tid; e < 64 * nvb; e += 512) { const int j = e / nvb, vb = e % nvb;
          const bf16x8 vv = *(const bf16x8*)(U + (size_t)(row0 + j) * NU + voff + vb * 8);
#pragma unroll
          for (int t = 0; t < 8; ++t) VT[(vb * 8 + t) * LP + j] = (bf16_t)vv[t]; } }
    if (pass == 1) {
        __syncthreads();
        const int dir = w >> 2, nt = w & 3; const LAS bf16_t* KH = dir ? KB : KF; bf16_t* So = dir ? Sb : Sf; const int d = nt * 16 + r;
        for (int mt = 0; mt < (DV >> 4); ++mt) { f32x4 acc = {0.f, 0.f, 0.f, 0.f}; acc = mma_tile<64>(VT + mt * 16 * LP, LP, KH + nt * 16 * LP, LP, acc, r, q);
            if (d < DK) {
#pragma unroll
                for (int j = 0; j < 4; ++j) So[(mt * 16 + q * 4 + j) * DK + d] = f2bf(acc[j]); } }
        if (tid < 64) dec[tid] = cumf[63 * 64 + tid]; else if (tid < 128) dec[NCH * 64 + tid - 64] = cumb[tid - 64];
        __syncthreads();
        return;
    }
    for (int e = tid; e < DV * 8; e += 512) { const int v = e >> 3, db = e & 7; u32x4 zf = {0u, 0u, 0u, 0u}, zb = zf;
        if (db * 8 < DK) { zf = *(const u32x4*)(Sf + v * DK + db * 8); zb = *(const u32x4*)(Sb + v * DK + db * 8); }
        *(LAS u32x4*)(STF + v * LP + db * 8) = zf; *(LAS u32x4*)(STB + v * LP + db * 8) = zb; }
    __syncthreads();
    { const int dir = w >> 2, rb = w & 3; const LAS bf16_t* Qd = dir ? QB : QF; const LAS bf16_t* Kd = dir ? KB : KF; LAS bf16_t* Pd = dir ? PB : PF;
#pragma unroll
      for (int nt = 0; nt < 4; ++nt) { f32x4 acc = {0.f, 0.f, 0.f, 0.f}; acc = mma_tile<64>(Qd + rb * 16 * LP, LP, Kd + nt * 16 * LP, LP, acc, r, q);
#pragma unroll
          for (int j = 0; j < 4; ++j) { const int i = rb * 16 + q * 4 + j, jj = nt * 16 + r; const bool keep = dir ? (jj >= i) : (jj <= i); Pd[i * LP + jj] = f2bf(keep ? acc[j] : 0.f); } } }
    __syncthreads();
    const int rb = w & 3, ch = w >> 2, NT = DV >> 5;
    f32x4 acc[3];
#pragma unroll
    for (int nt = 0; nt < 3; ++nt) { acc[nt] = (f32x4){0.f, 0.f, 0.f, 0.f};
        if (nt < NT) { const int v0 = (ch * NT + nt) * 16;
            acc[nt] = mma_tile<64>(PF + rb * 16 * LP, LP, VT + v0 * LP, LP, acc[nt], r, q);
            acc[nt] = mma_tile<64>(PB + rb * 16 * LP, LP, VT + v0 * LP, LP, acc[nt], r, q);
            acc[nt] = mma_tile<64>(QF + rb * 16 * LP, LP, STF + v0 * LP, LP, acc[nt], r, q);
            acc[nt] = mma_tile<64>(QB + rb * 16 * LP, LP, STB + v0 * LP, LP, acc[nt], r, q); } }
    float s1[4], s2[4];
#pragma unroll
    for (int j = 0; j < 4; ++j) { s1[j] = acc[0][j] + acc[1][j] + acc[2][j]; s2[j] = acc[0][j] * acc[0][j] + acc[1][j] * acc[1][j] + acc[2][j] * acc[2][j];
#pragma unroll
        for (int o = 1; o < 16; o <<= 1) { s1[j] += __shfl_xor(s1[j], o); s2[j] += __shfl_xor(s2[j], o); } }
    if (r == 0) {
#pragma unroll
        for (int j = 0; j < 4; ++j) { red[((rb * 2 + ch) * 16 + q * 4 + j) * 2] = s1[j]; red[((rb * 2 + ch) * 16 + q * 4 + j) * 2 + 1] = s2[j]; } }
    __syncthreads();
    const float invdv = 1.f / (float)DV;
#pragma unroll
    for (int j = 0; j < 4; ++j) { const int rr = q * 4 + j;
        const float t1 = red[((rb * 2) * 16 + rr) * 2] + red[((rb * 2 + 1) * 16 + rr) * 2], t2 = red[((rb * 2) * 16 + rr) * 2 + 1] + red[((rb * 2 + 1) * 16 + rr) * 2 + 1];
        const float mean = t1 * invdv; float mu, rstd;
        if (kind == 0) { mu = mean; rstd = rsqrtf(fmaxf(t2 * invdv - mean * mean, 0.f) + 1e-5f); } else { mu = 0.f; rstd = rsqrtf(t2 * invdv + 1e-5f); }
        const int row = row0 + rb * 16 + rr;
#pragma unroll
        for (int nt = 0; nt < 3; ++nt) if (nt < NT) { const int v = (ch * NT + nt) * 16 + r;
            const float nw = kind ? p.in[16][l * 96 + v] : p.in[11][l * 256 + h * 64 + v];
            const float g = bf2f(U[(size_t)row * NU + goff + v]);
            Y[(size_t)row * D + ycol + v] = f2bf((acc[nt][j] - mu) * rstd * nw * siluf_(g)); } }
    __syncthreads();
}

__device__ __forceinline__ void la_scan(const Params& p, int vb, int nvb) {
    for (int e = vb * 512 + vopaque((int)threadIdx.x); e < 32 * 4608; e += nvb * 512) {
        const int chain = e / 4608, el = e % 4608, kind = chain >> 4, dir = chain & 1;
        if (kind == 0 && el >= 4096) continue;
        const int DK = kind ? 48 : 64, d = el % DK, esz = kind ? 4608 : 4096;
        bf16_t* S = (kind ? (bf16_t*)(p.ws + WS_SGLA) + (size_t)(chain - 16) * NCH * 4608 : (bf16_t*)(p.ws + WS_SRET) + (size_t)chain * NCH * 4096) + el;
        const float* dec = (const float*)(p.ws + WS_DEC) + (size_t)chain * NCH * 64 + d;
        float acc = 0.f;
        for (int s = 0; s < NCH; s += 4) {
            int sl[4]; float t[4], dc[4];
#pragma unroll
            for (int u = 0; u < 4; ++u) { const int ss = s + u; sl[u] = dir ? (ss < 4 ? 3 - ss : 135 - ss) : ss; t[u] = bf2f(S[(size_t)sl[u] * esz]); dc[u] = __expf(dec[sl[u] * 64]); }
#pragma unroll
            for (int u = 0; u < 4; ++u) { S[(size_t)sl[u] * esz] = f2bf(acc); acc = acc * dc[u] + t[u]; }
        }
    }
}

__device__ __forceinline__ float rw_conv(const bf16_t* U, const float* cw, int row, int t, int tmax, int col) {
    const bf16_t* uc = U + (size_t)row * NU + 2208 + col; float x = cw[1472 + col] * bf2f(uc[0]);
    if (t > 0) x += cw[col] * bf2f(uc[-NU]);
    if (t + 1 < tmax) x += cw[2944 + col] * bf2f(uc[NU]);
    return x;
}
__device__ __forceinline__ void rwkv_seq(const Params& p, int l, int chain, bool last, LAS unsigned char* lds) {
    const int tid = vopaque((int)threadIdx.x), lane = tid & 63, w = tid >> 6;
    const int b = chain / 12, h = (chain % 12) >> 1, dir = chain & 1;
    LAS float* Rr = (LAS float*)lds; LAS float* Kk = Rr + 4096; LAS float* Vv = Kk + 4096; LAS float* LW = Vv + 4096; LAS float* LA = LW + 4096; LAS float* KK = LA + 4096;
    LAS float* red = KK + 4096; LAS float* ored = red + 1024;
    const bf16_t* U = (const bf16_t*)(p.ws + WS_U);
    const float* cw = p.in[17] + l * 3 * 1472;
    const float* w0 = (dir ? p.in[20] : p.in[18]) + l * 384 + h * 64; const float* w2 = (dir ? p.in[21] : p.in[19]) + l * 64 * 384 + h * 64;
    const float* a0 = p.in[22] + l * 384 + h * 64; const float* a2 = p.in[23] + l * 64 * 384 + h * 64;
    const float* kkw = p.in[25] + l * 384 + h * 64; const float* kaw = p.in[26] + l * 384 + h * 64;
    bf16_t* O = (bf16_t*)(p.ws + WS_ORW) + (size_t)dir * MALL * 384;
    float S[8];
#pragma unroll
    for (int j = 0; j < 8; ++j) S[j] = 0.f;
    const int v = lane, kq = w;
    for (int s = 0; s < NCH; ++s) {
        const int cs = dir ? (s < 4 ? 3 - s : 135 - s) : s;
        const int row0 = chunk_row0(b, cs), t0 = cs < 4 ? cs * 64 : (cs - 4) * 64, tmax = cs < 4 ? CTXL : SEQ;
        const bool wr_o = !(last && cs < 4);
        for (int e = tid; e < 5 * 4096; e += 512) { const int grp = e >> 12, i = (e >> 6) & 63, c = e & 63;
            const int col = grp == 0 ? h * 64 + c : grp == 1 ? 384 + h * 64 + c : grp == 2 ? 768 + h * 64 + c : grp == 3 ? (dir ? 1216 : 1152) + c : 1280 + c;
            float x = rw_conv(U, cw, row0 + i, t0 + i, tmax, col);
            if (grp == 3) x = tanhf(x);
            LAS float* dst = grp == 0 ? Rr : grp == 1 ? Kk : grp == 2 ? Vv : grp == 3 ? LW : LA;
            dst[i * 64 + c] = x; }
        __syncthreads();
        for (int jj = 0; jj < 8; ++jj) { const int i = w + 8 * jj, hd = lane;
            float za = a0[hd], zw = w0[hd];
#pragma unroll 8
            for (int rr = 0; rr < 64; ++rr) { za += LA[i * 64 + rr] * a2[rr * 384 + hd]; zw += LW[i * 64 + rr] * w2[rr * 384 + hd]; }
            const float a = sigmoidf_(za);
            const float sp = (-zw > 20.f) ? -zw : __logf(1.f + __expf(-zw));
            const float wdec = __expf(-__expf(-sp - 0.5f));
            const float kraw = Kk[i * 64 + hd]; float kk = kraw * kkw[hd]; const float n2 = wave_sum(kk * kk); kk *= rsqrtf(fmaxf(n2, 1e-24f));
            const float k2 = kraw * (1.f + (a - 1.f) * kaw[hd]);
            LW[i * 64 + hd] = wdec; LA[i * 64 + hd] = kk * a; KK[i * 64 + hd] = kk; Kk[i * 64 + hd] = k2; }
        __syncthreads();
        for (int st = 0; st < 64; ++st) { const int i = dir ? 63 - st : st, pb = st & 1;
            float part = 0.f;
#pragma unroll
            for (int j = 0; j < 8; ++j) part -= S[j] * KK[i * 64 + kq * 8 + j];
            red[(pb * 8 + kq) * 64 + v] = part;
            __syncthreads();
            float sa = 0.f;
#pragma unroll
            for (int g = 0; g < 8; ++g) sa += red[(pb * 8 + g) * 64 + v];
            if (w == 0 && st > 0) { const int ip = dir ? 64 - st : st - 1; float o = 0.f;
#pragma unroll
                for (int g = 0; g < 8; ++g) o += ored[((pb ^ 1) * 8 + g) * 64 + v];
                if (wr_o) O[(size_t)(row0 + ip) * 384 + h * 64 + v] = f2bf(o); }
            const float vv = Vv[i * 64 + v]; float op = 0.f;
#pragma unroll
            for (int j = 0; j < 8; ++j) { const int k = kq * 8 + j; S[j] = S[j] * LW[i * 64 + k] + sa * LA[i * 64 + k] + vv * Kk[i * 64 + k]; op += S[j] * Rr[i * 64 + k]; }
            ored[(pb * 8 + kq) * 64 + v] = op;
        }
        __syncthreads();
        if (w == 0) { const int ip = dir ? 0 : 63; float o = 0.f;
#pragma unroll
            for (int g = 0; g < 8; ++g) o += ored[(8 + g) * 64 + v];
            if (wr_o) O[(size_t)(row0 + ip) * 384 + h * 64 + v] = f2bf(o); }
        __syncthreads();
    }
}
__device__ __forceinline__ void rwkv_finish_item(const Params& p, int l, int idx, bool last, LAS unsigned char* lds) {
    const int tid = vopaque((int)threadIdx.x), lane = tid & 63, w = tid >> 6;
    const int b = idx / 792, rem = idx % 792, cs = rem / 6, h = rem % 6;
    if (last && cs < 4) return;
    const int row0 = chunk_row0(b, cs), t0 = cs < 4 ? cs * 64 : (cs - 4) * 64, tmax = cs < 4 ? CTXL : SEQ;
    const bf16_t* U = (const bf16_t*)(p.ws + WS_U); bf16_t* Y = (bf16_t*)(p.ws + WS_Y); const bf16_t* O = (const bf16_t*)(p.ws + WS_ORW);
    const float* cw = p.in[17] + l * 3 * 1472;
    const float* a0 = p.in[22] + l * 384 + h * 64; const float* a2 = p.in[23] + l * 64 * 384 + h * 64; const float* g2 = p.in[24] + l * 128 * 384 + h * 64;
    const float* kaw = p.in[26] + l * 384 + h * 64; const float* rkw = p.in[27] + l * 384 + h * 64;
    const float* lnw = p.in[28] + l * 384 + h * 64; const float* lnb = p.in[29] + l * 384 + h * 64;
    LAS float* LA = (LAS float*)lds; LAS float* LG = LA + 4096;
    for (int e = tid; e < 64 * 192; e += 512) { const int i = e / 192, c = e % 192; const float x = rw_conv(U, cw, row0 + i, t0 + i, tmax, 1280 + c);
        if (c < 64) LA[i * 64 + c] = x; else LG[i * 128 + c - 64] = sigmoidf_(x); }
    __syncthreads();
    for (int jj = 0; jj < 8; ++jj) { const int i = w + 8 * jj, hd = lane, row = row0 + i, t = t0 + i;
        const float rv = rw_conv(U, cw, row, t, tmax, h * 64 + hd), kv = rw_conv(U, cw, row, t, tmax, 384 + h * 64 + hd), vv = rw_conv(U, cw, row, t, tmax, 768 + h * 64 + hd);
        float za = a0[hd], g = 0.f;
#pragma unroll 8
        for (int rr = 0; rr < 64; ++rr) za += LA[i * 64 + rr] * a2[rr * 384 + hd];
#pragma unroll 8
        for (int rr = 0; rr < 128; ++rr) g += LG[i * 128 + rr] * g2[rr * 384 + hd];
        const float a = sigmoidf_(za), k2 = kv * (1.f + (a - 1.f) * kaw[hd]);
        const float rk = wave_sum(rv * k2 * rkw[hd]);
        const float o = bf2f(O[(size_t)row * 384 + h * 64 + hd]) + bf2f(O[(size_t)MALL * 384 + (size_t)row * 384 + h * 64 + hd]);
        const float mu = wave_sum(o) * (1.f / 64.f), dl = o - mu, var = wave_sum(dl * dl) * (1.f / 64.f);
        const float yv = dl * rsqrtf(var + 64e-5f) * lnw[hd] + lnb[hd] + rk * vv;
        Y[(size_t)row * D + 640 + h * 64 + hd] = f2bf(yv * g); }
    __syncthreads();
}

__device__ __forceinline__ int opaque(int v) { asm volatile("" : "+s"(v)); return v; }
__global__ void __launch_bounds__(512, 2) fwd_kernel(Params p) {
    extern __shared__ __attribute__((aligned(16))) unsigned char lds_raw[];
    LAS unsigned char* lds = (LAS unsigned char*)lds_raw;
    cg::grid_group grid = cg::this_grid();
    const int bid = blockIdx.x, G = gridDim.x;
    unsigned char* ws = p.ws;
    const float* modv = (const float*)(ws + WS_MOD);
    float* ctxb = (float*)(ws + WS_CTX);
    bf16_t* XN = (bf16_t*)(ws + WS_Y); bf16_t* Ub = (bf16_t*)(ws + WS_U); float* Cb = (float*)(ws + WS_U); bf16_t* Hb = (bf16_t*)(ws + WS_U); float* C2 = (float*)(ws + WS_C2);

    if (PHM & 1) mod_phase(p, lds, bid, G);
    __syncthreads();
    if (PHM & 2048) wconv_items(p, 0, 0, lds, bid, G);
    grid.sync();
    if (PHM & 1024) row_phase(p.in[0], p.in[2], nullptr, nullptr, nullptr, 0, nullptr, nullptr, p.in[6], modv, 0, 1024, XN, MALL, bid, G);
    grid.sync();
    for (int l = 0; l < 2; ++l) {
        const bool last = (l == 1); const int M = last ? MLAT : MALL;
        const float* modl = modv + l * 3 * 6144;
        if (PHM & 2) { pg8::Gemm g{XN, (const bf16_t*)(ws + WS_WIN), opaque(MALL), opaque(NU), opaque(D)}; pg8::StaticOrder S; S.init(g.M, g.N, G, bid); pg8::EpiBf16<0> E{Ub, NU, nullptr, 0, 0};
          pg8::gemm_phase<pg8::EpiBf16<0>, pg8::StaticOrder>(lds, g, S, E, nullptr); }
        grid.sync();
        if (PHM & 4) for (int it = bid; it < 2112; it += G) la_item(p, l, it, 1, last, lds);
        if (PHM & 2048) { wconv_items(p, l, 1, lds, bid, G);
        if (l == 0) wconv_items(p, 1, 0, lds, bid, G); }
        grid.sync();
        if (bid < 24) { if (PHM & 8) rwkv_seq(p, l, bid, last, lds); } else { if (PHM & 16) la_scan(p, bid - 24, G - 24); }
        grid.sync();
        for (int it = bid; it < 2112 + 1584; it += G) { if (it < 2112) { if (PHM & 32) la_item(p, l, it, 3, last, lds); } else { if (PHM & 64) rwkv_finish_item(p, l, it - 2112, last, lds); } }
        grid.sync();
        if (PHM & 128) { pg8::Gemm g{XN, (const bf16_t*)(ws + WS_WOUT), opaque(M), opaque(D), opaque(D)}; pg8::StaticOrder S; S.init(g.M, g.N, G, bid); pg8::EpiF32 E{Cb, D, nullptr};
          pg8::gemm_phase<pg8::EpiF32, pg8::StaticOrder>(lds, g, S, E, nullptr); }
        grid.sync();
        if (PHM & 1024) row_phase(l == 0 ? p.in[0] : p.out, l == 0 ? p.in[2] : ctxb, Cb, p.in[7] + l * D, modl, 2048, p.out, ctxb, p.in[8] + l * D, modl, 3072, 4096, XN, M, bid, G);
        grid.sync();
        if (PHM & 256) { pg8::Gemm g{XN, (const bf16_t*)(ws + WS_WGU), opaque(M), opaque(NGU), opaque(D)}; pg8::StaticOrder S; S.init(g.M, g.N, G, bid); pg8::EpiSwiGLU E{Hb, FF};
          pg8::gemm_phase<pg8::EpiSwiGLU, pg8::StaticOrder>(lds, g, S, E, nullptr); }
        grid.sync();
        if (PHM & 512) { pg8::Gemm g{Hb, (const bf16_t*)(ws + WS_WDN), opaque(M), opaque(D), opaque(FF)}; pg8::StaticOrder S; S.init(g.M, g.N, G, bid); pg8::EpiF32 E{C2, D, nullptr};
          pg8::gemm_phase<pg8::EpiF32, pg8::StaticOrder>(lds, g, S, E, nullptr); }
        grid.sync();
        if (PHM & 1024) row_phase(p.out, ctxb, C2, p.in[9] + l * D, modl, 5120, p.out, ctxb, last ? nullptr : p.in[6] + (l + 1) * D, modv + (l + 1) * 3 * 6144, 0, 1024, last ? nullptr : XN, M, bid, G);
        if (!last) grid.sync();
    }
}

extern "C" void kernel_launch(void* const* d_in, const int* in_sizes, int n_in, void* d_out, int out_size, void* d_ws, size_t ws_size, hipStream_t stream) {
    static int grid_blocks = 0;
    if (!grid_blocks) {
        int dev = 0, cus = 0, per_cu = 0;
        hipGetDevice(&dev);
        hipDeviceGetAttribute(&cus, hipDeviceAttributeMultiprocessorCount, dev);
        if (hipFuncSetAttribute((const void*)fwd_kernel, hipFuncAttributeMaxDynamicSharedMemorySize, LDS_BYTES) != hipSuccess) fprintf(stderr, "hipFuncSetAttribute failed\n");
        if (hipOccupancyMaxActiveBlocksPerMultiprocessor(&per_cu, (const void*)fwd_kernel, 512, LDS_BYTES) != hipSuccess || per_cu < 1) { fprintf(stderr, "occupancy query: %d\n", per_cu); per_cu = 1; }
        (void)hipGetLastError();
        grid_blocks = cus;
        if (ws_size < WS_END) fprintf(stderr, "workspace too small: %zu < %zu\n", ws_size, (size_t)WS_END);
    }
    Params p{};
    for (int i = 0; i < 34; ++i) p.in[i] = (const float*)d_in[i];
    p.out = (float*)d_out; p.ws = (unsigned char*)d_ws;
    void* args[] = {&p};
    hipError_t e = hipLaunchCooperativeKernel((const void*)fwd_kernel, dim3(grid_blocks), dim3(512), args, LDS_BYTES, stream);
    if (e != hipSuccess) fprintf(stderr, "cooperative launch failed: %s (grid %d)\n", hipGetErrorString(e), grid_blocks);
}
```

```cpp
#include <hip/hip_runtime.h>
#include <hip/hip_cooperative_groups.h>
#include <cstdio>
namespace cg = cooperative_groups;
namespace pg8 {
__device__ __forceinline__ int vopq(int v) { asm volatile("" : "+v"(v)); return v; }
#define PG8_LAS __attribute__((address_space(3)))
typedef unsigned short bf16_t;
typedef short bf16x8 __attribute__((ext_vector_type(8)));
typedef float f32x4 __attribute__((ext_vector_type(4)));
typedef unsigned u32x4 __attribute__((ext_vector_type(4)));
constexpr int BM = 256, BK = 64, HALF = 128, HTB = HALF * BK * 2  , STAGE_BYTES = 8 * HTB, NXCD = 8, WGM = 8;

__host__ __device__ __forceinline__ int lds_byte(int r, int c) { const int st = (r >> 4) * 2 + (c >> 5), rr = r & 15, cc = c & 31, ob = rr * 64 + cc * 2; return st * 1024 + (ob ^ (((ob >> 9) & 1) << 5)); }
__host__ __device__ __forceinline__ void stage_rc(int b, int& R, int& C) { const int st = b / 1024, sb = b % 1024, swz = sb ^ (((sb >> 9) & 1) << 5); R = (st >> 1) * 16 + swz / 64; C = (st & 1) * 32 + (swz % 64) / 2; }
__host__ __device__ __forceinline__ int perm32(int rho) { const int n = rho >> 4, i = rho & 15; return 8 * (i >> 2) + 4 * n + (i & 3); }

struct Unit { int pm, pn; };
struct Gemm { const bf16_t* A; const bf16_t* Bt; int M, N, K; };

struct StaticOrder {
    int nM, nN, nwg, G, c;
    __host__ __device__ void init(int M, int N, int G_, int c_) { nM = M / BM; nN = N / BM; nwg = nM * nN; G = G_; c = c_; }
    __host__ __device__ bool next(int i, Unit& u) const {
        const long L = (long)i * G + c; if (L >= nwg) return false;
        int wgid = (int)L; { const int q = nwg / NXCD, r = nwg % NXCD, xcd = wgid % NXCD, off = wgid / NXCD; wgid = (xcd < r ? xcd * (q + 1) : r * (q + 1) + (xcd - r) * q) + off; }
        const int nig = WGM * nN, gid = wgid / nig, fm = gid * WGM, gsz = (nM - fm) < WGM ? (nM - fm) : WGM;
        u.pm = fm + ((wgid % nig) % gsz); u.pn = (wgid % nig) / gsz; return true;
    }
    __device__ __forceinline__ void a_ready(const Unit&) const {}
    __device__ __forceinline__ void done(const Unit&) const {}
};
__device__ __forceinline__ unsigned cvt_pk_bf16(float lo, float hi) { unsigned r; asm volatile("v_cvt_pk_bf16_f32 %0, %1, %2" : "=v"(r) : "v"(lo), "v"(hi)); return r; }
typedef float f32x2 __attribute__((ext_vector_type(2)));
__device__ __forceinline__ f32x2 gelu_pk(f32x2 v) {
    const f32x2 av = __builtin_elementwise_abs(v), d = av * 0.2316418882f + 1.0f;
    f32x2 t; t.x = __builtin_amdgcn_rcpf(d.x); t.y = __builtin_amdgcn_rcpf(d.y);
    f32x2 q = t * 0.5307027145f + (-0.7265760135f); q = q * t + 0.7107068705f; q = q * t + (-0.142248368f); q = q * t + 0.127414796f; q = q * t;
    const f32x2 s = (v * v) * (-0.72134752044f);
    f32x2 e; e.x = __builtin_amdgcn_exp2f(s.x); e.y = __builtin_amdgcn_exp2f(s.y);
    const f32x2 m = v * (q * e), r = v - m;
    f32x2 o; o.x = v.x < 0.f ? m.x : r.x; o.y = v.y < 0.f ? m.y : r.y; return o;
}

struct EpiF32 {
    static constexpr bool PERM = false, AFTER_DRAIN = false;
    float* C; int ldc; const float* bias;
    __device__ __forceinline__ void operator()(const f32x4 (&acc)[2][2][4][2], const Unit& u, int wr, int wc, int fr, int fq) const {
        const int row0 = u.pm * BM + wr * 64 + fr, col0 = u.pn * BM + wc * 32 + 4 * fq;
        f32x4 bv[2][2];
#pragma unroll
        for (int bj = 0; bj < 2; ++bj)
#pragma unroll
            for (int n = 0; n < 2; ++n) bv[bj][n] = bias ? *(const f32x4*)(bias + col0 + bj * HALF + n * 16) : (f32x4){0.f, 0.f, 0.f, 0.f};
#pragma unroll
        for (int ai = 0; ai < 2; ++ai)
#pragma unroll
            for (int m = 0; m < 4; ++m) { float* rowp = C + (size_t)(row0 + ai * HALF + m * 16) * ldc + col0;
#pragma unroll
                for (int bj = 0; bj < 2; ++bj)
#pragma unroll
                    for (int n = 0; n < 2; ++n) *(f32x4*)(rowp + bj * HALF + n * 16) = acc[ai][bj][m][n] + bv[bj][n]; }
    }
};
template <int ACT  > struct EpiBf16 {
    static constexpr bool PERM = true, AFTER_DRAIN = false;
    bf16_t* O; int ldc; const float* bias; int split_cols; size_t split_stride;
    __device__ __forceinline__ void operator()(const f32x4 (&acc)[2][2][4][2], const Unit& u, int wr, int wc, int fr, int fq) const {
        const int row0 = u.pm * BM + wr * 64 + fr; int colt = u.pn * BM; bf16_t* base = O;
        if (split_cols) { const int t = colt / split_cols; base += (size_t)t * split_stride; colt -= t * split_cols; }
        const int col0 = colt + wc * 32 + 8 * fq, bcol0 = u.pn * BM + wc * 32 + 8 * fq;
        f32x4 bv[2][2];
#pragma unroll
        for (int bj = 0; bj < 2; ++bj)
#pragma unroll
            for (int n = 0; n < 2; ++n) bv[bj][n] = bias ? *(const f32x4*)(bias + bcol0 + bj * HALF + 4 * n) : (f32x4){0.f, 0.f, 0.f, 0.f};
#pragma unroll
        for (int ai = 0; ai < 2; ++ai)
#pragma unroll
            for (int m = 0; m < 4; ++m) { bf16_t* rowp = base + (size_t)(row0 + ai * HALF + m * 16) * ldc + col0;
#pragma unroll
                for (int bj = 0; bj < 2; ++bj) { f32x4 v0 = acc[ai][bj][m][0] + bv[bj][0], v1 = acc[ai][bj][m][1] + bv[bj][1];
                    if (ACT == 1) { f32x2 a = gelu_pk((f32x2){v0[0], v0[1]}), b = gelu_pk((f32x2){v0[2], v0[3]}), c = gelu_pk((f32x2){v1[0], v1[1]}), d = gelu_pk((f32x2){v1[2], v1[3]});
                        v0 = (f32x4){a.x, a.y, b.x, b.y}; v1 = (f32x4){c.x, c.y, d.x, d.y}; }
                    if (ACT == 2) {
#pragma unroll
                        for (int j = 0; j < 4; ++j) { v0[j] = 0.5f * v0[j] * (1.0f + erff(v0[j] * 0.70710678f)); v1[j] = 0.5f * v1[j] * (1.0f + erff(v1[j] * 0.70710678f)); } }
                    u32x4 w; w.x = cvt_pk_bf16(v0[0], v0[1]); w.y = cvt_pk_bf16(v0[2], v0[3]); w.z = cvt_pk_bf16(v1[0], v1[1]); w.w = cvt_pk_bf16(v1[2], v1[3]);
                    *(u32x4*)(rowp + bj * HALF) = w; } }
    }
};
template <class Epi, class Sched, bool STAMP = false>
__device__ __forceinline__ void gemm_phase(PG8_LAS unsigned char* lds, const Gemm g, const Sched& S, const Epi& E, unsigned long long* stamps) {
    const int tid = vopq((int)threadIdx.x), wid = __builtin_amdgcn_readfirstlane(tid >> 6), lane = tid & 63, wr = wid >> 2, wc = wid & 3, fr = lane & 15, fq = lane >> 4;
    const int K = g.K, nt = K / BK;
    int ts_lo = 0, ts_hi = 0, nts = 0; const unsigned long long rt_entry = STAMP ? (unsigned long long)wall_clock64() : 0ull;
#define PG8_STAMP() do { if (STAMP && wid == 0 && nts < 64) { const unsigned long long _c = (unsigned long long)clock64(); \
        ts_lo = (lane == nts) ? (int)(unsigned)_c : ts_lo; ts_hi = (lane == nts) ? (int)(unsigned)(_c >> 32) : ts_hi; ++nts; } } while (0)
    PG8_STAMP();
    unsigned voffA[2], voffB[2];
#pragma unroll
    for (int i = 0; i < 2; ++i) { int R, C; stage_rc(tid * 16 + i * 8192, R, C); const int Rb = Epi::PERM ? ((R & ~31) + perm32(R & 31)) : R;
        voffA[i] = (unsigned)(R * K + C) * 2u; voffB[i] = (unsigned)(Rb * K + C) * 2u; }
    const size_t kstep = (size_t)(BK * 2);
    const size_t hstep = (size_t)HALF * K * 2;
    const size_t tstep = 2 * hstep;
    const unsigned ldsw = (unsigned)wid * 1024u;
    const int aoff = lds_byte(wr * 64 + fr, fq * 8), boff = lds_byte(wc * 32 + fr, fq * 8);
#define PG8_SA(b, h) (((b) * 2 + (h)) * HTB)
#define PG8_SB(b, h) ((4 + (b) * 2 + (h)) * HTB)
#define PG8_STAGE(bufoff, gbase, voff) do { _Pragma("unroll") for (int _i = 0; _i < 2; ++_i) \
        __builtin_amdgcn_global_load_lds((const unsigned*)((const char*)(gbase) + (voff)[_i]), (PG8_LAS unsigned*)(lds + (bufoff) + ldsw + _i * 8192), 16, 0, 0); } while (0)
#define PG8_LDA(dst, b, h) do { _Pragma("unroll") for (int m = 0; m < 4; ++m) _Pragma("unroll") for (int k = 0; k < 2; ++k) dst[m][k] = *(const PG8_LAS bf16x8*)(lds + PG8_SA(b, h) + aoff + m * 2048 + k * 1024); } while (0)
#define PG8_LDB(dst, b, h) do { _Pragma("unroll") for (int n = 0; n < 2; ++n) _Pragma("unroll") for (int k = 0; k < 2; ++k) dst[n][k] = *(const PG8_LAS bf16x8*)(lds + PG8_SB(b, h) + boff + n * 2048 + k * 1024); } while (0)
#define PG8_MMA(ai, bj, At, Bt) do { __builtin_amdgcn_s_setprio(1); _Pragma("unroll") for (int m = 0; m < 4; ++m) _Pragma("unroll") for (int n = 0; n < 2; ++n) _Pragma("unroll") for (int k = 0; k < 2; ++k) \
        acc[ai][bj][m][n] = __builtin_amdgcn_mfma_f32_16x16x32_bf16(Bt[n][k], At[m][k], acc[ai][bj][m][n], 0, 0, 0); __builtin_amdgcn_s_setprio(0); } while (0)
#define PG8_WAIT_V(n) asm volatile("s_waitcnt vmcnt(" #n ")" ::: "memory")
#define PG8_WAIT_L(n) asm volatile("s_waitcnt lgkmcnt(" #n ")" ::: "memory")
#define PG8_BAR __builtin_amdgcn_s_barrier()
#define PG8_SCHED __builtin_amdgcn_sched_barrier(0)
    Unit cur, nxt; int ui = 0;
    if (!S.next(0, cur)) return;
    f32x4 acc[2][2][4][2];
#pragma unroll
    for (int a = 0; a < 2; ++a)
#pragma unroll
        for (int b = 0; b < 2; ++b)
#pragma unroll
            for (int m = 0; m < 4; ++m)
#pragma unroll
                for (int n = 0; n < 2; ++n) acc[a][b][m][n] = (f32x4){0.f, 0.f, 0.f, 0.f};
    bf16x8 At[4][2], B0[2][2], B1[2][2];
    const char* cA = (const char*)g.A + (size_t)cur.pm * tstep; const char* cB = (const char*)g.Bt + (size_t)cur.pn * tstep;
    S.a_ready(cur);
    PG8_STAGE(PG8_SB(0, 0), cB, voffB); PG8_STAGE(PG8_SA(0, 0), cA, voffA); PG8_STAGE(PG8_SB(0, 1), cB + hstep, voffB); PG8_STAGE(PG8_SA(0, 1), cA + hstep, voffA);
    if (wr == 1) PG8_BAR;
    PG8_WAIT_V(4); PG8_BAR;
    PG8_STAGE(PG8_SB(1, 0), cB + kstep, voffB); PG8_STAGE(PG8_SA(1, 0), cA + kstep, voffA); PG8_STAGE(PG8_SB(1, 1), cB + hstep + kstep, voffB);
    PG8_WAIT_V(6); PG8_BAR;
    PG8_STAMP();
    for (;;) {
        const bool has_next = S.next(ui + 1, nxt);
        const char* nA = has_next ? (const char*)g.A + (size_t)nxt.pm * tstep : cA; const char* nB = has_next ? (const char*)g.Bt + (size_t)nxt.pn * tstep : cB;
        for (int t = 0; t < nt; t += 2) {
            const bool last = (t == nt - 2);
            const char* a1 = cA + (size_t)(t + 1) * kstep;
            const char* a2 = last ? nA : cA + (size_t)(t + 2) * kstep; const char* b2 = last ? nB : cB + (size_t)(t + 2) * kstep;
            const char* a3 = a2 + kstep; const char* b3 = b2 + kstep;
            if (last && has_next) S.a_ready(nxt);
            PG8_LDB(B0, 0, 0); PG8_SCHED; PG8_LDA(At, 0, 0); PG8_STAGE(PG8_SA(1, 1), a1 + hstep, voffA);
            PG8_WAIT_L(8); PG8_BAR; PG8_WAIT_L(0); PG8_MMA(0, 0, At, B0); PG8_BAR; PG8_SCHED;
            PG8_LDB(B1, 0, 1); PG8_STAGE(PG8_SB(0, 0), b2, voffB);
            PG8_BAR; PG8_WAIT_L(0); PG8_MMA(0, 1, At, B1); PG8_BAR;
            PG8_LDA(At, 0, 1); PG8_STAGE(PG8_SA(0, 0), a2, voffA);
            PG8_BAR; PG8_WAIT_L(0); PG8_MMA(1, 0, At, B0); PG8_BAR; PG8_SCHED;
            PG8_STAGE(PG8_SB(0, 1), b2 + hstep, voffB);
            PG8_WAIT_V(6); PG8_BAR; PG8_MMA(1, 1, At, B1); PG8_BAR;
            PG8_LDB(B0, 1, 0); PG8_SCHED; PG8_LDA(At, 1, 0); PG8_STAGE(PG8_SA(0, 1), a2 + hstep, voffA);
            PG8_WAIT_L(8); PG8_BAR; PG8_WAIT_L(0); PG8_MMA(0, 0, At, B0); PG8_BAR; PG8_SCHED;
            PG8_LDB(B1, 1, 1); PG8_STAGE(PG8_SB(1, 0), b3, voffB);
            PG8_BAR; PG8_WAIT_L(0); PG8_MMA(0, 1, At, B1); PG8_BAR;
            PG8_LDA(At, 1, 1); PG8_STAGE(PG8_SA(1, 0), a3, voffA);
            PG8_BAR; PG8_WAIT_L(0); PG8_MMA(1, 0, At, B0); PG8_BAR; PG8_SCHED;
            PG8_STAGE(PG8_SB(1, 1), b3 + hstep, voffB);
            PG8_WAIT_V(6); PG8_BAR; PG8_MMA(1, 1, At, B1); PG8_BAR;
        }
        PG8_STAMP();
        if constexpr (!Epi::AFTER_DRAIN) { E(acc, cur, wr, wc, fr, fq); S.done(cur); }
        PG8_STAMP();
        if (!has_next) break;
#pragma unroll
        for (int a = 0; a < 2; ++a)
#pragma unroll
            for (int b = 0; b < 2; ++b)
#pragma unroll
                for (int m = 0; m < 4; ++m)
#pragma unroll
                    for (int n = 0; n < 2; ++n) acc[a][b][m][n] = (f32x4){0.f, 0.f, 0.f, 0.f};
        cur = nxt; cA = nA; cB = nB; ++ui;
    }
    PG8_WAIT_V(0);
    if (wr == 0) PG8_BAR;
    PG8_BAR;
    if constexpr (Epi::AFTER_DRAIN) { E.fused(acc, cur, wr, wc, fr, fq, lds, wid, lane); S.done(cur); }
    PG8_STAMP();
    if (STAMP && wid == 0) { stamps[lane] = lane < nts ? (((unsigned long long)(unsigned)ts_hi << 32) | (unsigned)ts_lo) : 0ull;
        if (lane == 62) stamps[62] = rt_entry; if (lane == 63) stamps[63] = (unsigned long long)wall_clock64(); }
#undef PG8_STAMP
#undef PG8_SA
#undef PG8_SB
#undef PG8_STAGE
#undef PG8_LDA
#undef PG8_LDB
#undef PG8_MMA
#undef PG8_WAIT_V
#undef PG8_WAIT_L
#undef PG8_BAR
#undef PG8_SCHED
}
}
namespace pg8 {
struct EpiSwiGLU {
    static constexpr bool PERM = true, AFTER_DRAIN = false;
    bf16_t* H; int ldh;
    __device__ __forceinline__ void operator()(const f32x4 (&acc)[2][2][4][2], const Unit& u, int wr, int wc, int fr, int fq) const {
        const int row0 = u.pm * BM + wr * 64 + fr, col0 = u.pn * HALF + wc * 32 + 8 * fq;
#pragma unroll
        for (int ai = 0; ai < 2; ++ai)
#pragma unroll
            for (int m = 0; m < 4; ++m) { bf16_t* rowp = H + (size_t)(row0 + ai * HALF + m * 16) * ldh + col0;
                float hv[8];
#pragma unroll
                for (int n = 0; n < 2; ++n)
#pragma unroll
                    for (int j = 0; j < 4; ++j) { const float g = acc[ai][0][m][n][j], up = acc[ai][1][m][n][j]; hv[n * 4 + j] = g * up * __builtin_amdgcn_rcpf(1.0f + __expf(-g)); }
                u32x4 w; w.x = cvt_pk_bf16(hv[0], hv[1]); w.y = cvt_pk_bf16(hv[2], hv[3]); w.z = cvt_pk_bf16(hv[4], hv[5]); w.w = cvt_pk_bf16(hv[6], hv[7]);
                *(u32x4*)rowp = w; }
    }
};
}

#define LAS __attribute__((address_space(3)))
typedef unsigned short bf16_t;
typedef short bf16x8 __attribute__((ext_vector_type(8)));
typedef float f32x4 __attribute__((ext_vector_type(4)));
typedef unsigned u32x4 __attribute__((ext_vector_type(4)));
typedef unsigned u32x2 __attribute__((ext_vector_type(2)));

constexpr int D = 1024, MLAT = 16384, MCTX = 512, MALL = 16896, SEQ = 8192, CTXL = 256, NCH = 132;
constexpr int INW = 3680, NU = 3840, FF = 2816, NGU = 5632;
constexpr size_t WS_MOD = 0;
constexpr size_t WS_CTX = 147456;
constexpr size_t WS_WA = WS_CTX + (size_t)MCTX * D * 4;
constexpr size_t WA_BYTES = (size_t)3168 * 8192;
constexpr size_t WS_WGU = WS_WA;
constexpr size_t WS_WDN = WS_WGU + (size_t)NGU * D * 2;
constexpr size_t WS_WIN = WS_WDN + (size_t)D * FF * 2;
constexpr size_t WS_RWN = WS_WA;
static_assert(WS_WIN + (size_t)NU * D * 2 <= WS_WA + WA_BYTES, "region A");
constexpr size_t WS_WOUT = WS_WA + WA_BYTES;
constexpr size_t WS_U = WS_WOUT + (size_t)D * D * 2;
constexpr size_t U_BYTES = (size_t)MALL * NU * 2;
constexpr size_t H_BYTES = (size_t)MALL * FF * 2;
constexpr size_t C_BYTES = (size_t)MALL * D * 4;
constexpr size_t WS_C2 = WS_U + H_BYTES;
constexpr size_t WS_RWM = WS_U + U_BYTES;
constexpr size_t WS_RWP = WS_RWM + (size_t)3168 * 8192;
constexpr size_t WS_W2T = WS_RWP + (size_t)3168 * 256;
constexpr size_t WS_ACT = WS_W2T + (size_t)6 * 20480 * 2;
constexpr size_t WS_Y = WS_C2 + C_BYTES;
constexpr size_t WS_SRET = WS_Y + (size_t)MALL * D * 2;
constexpr size_t WS_SGLA = WS_SRET + (size_t)16 * NCH * 4096 * 2;
constexpr size_t WS_DEC = WS_SGLA + (size_t)16 * NCH * 4608 * 2;
constexpr size_t WS_END = WS_DEC + (size_t)32 * NCH * 64 * 4;
static_assert(WS_ACT + (size_t)MALL * 192 * 2 <= WS_Y, "tail overlaps y");
constexpr size_t WS_BAR = WS_END;
constexpr int CTL_WORDS = 3456 + 512;
static_assert(WS_BAR + CTL_WORDS * 4 <= (size_t)268435456, "workspace too large");
constexpr int LDS_BYTES = 163840;
#ifndef PHM
#define PHM 0xFFFF
#endif

struct Params { const float* in[34]; float* out; unsigned char* ws; };

__device__ __forceinline__ int opaque(int v) { asm volatile("" : "+s"(v)); return v; }
__device__ __forceinline__ int vopaque(int v) { asm volatile("" : "+v"(v)); return v; }
typedef __bf16 bf16v2_t __attribute__((ext_vector_type(2)));
typedef float f32x2_t __attribute__((ext_vector_type(2)));
__device__ __forceinline__ unsigned pk2(float lo, float hi) { const f32x2_t v = {lo, hi}; const bf16v2_t b = __builtin_convertvector(v, bf16v2_t); return __builtin_bit_cast(unsigned, b); }
__device__ __forceinline__ bf16_t f2bf(float f) { return (bf16_t)(pk2(f, 0.f) & 0xffffu); }
__device__ __forceinline__ float bf2f(bf16_t b) { return __uint_as_float(((unsigned)b) << 16); }
template <int CTRL, int RMASK> __device__ __forceinline__ float dpp_(float v) { return __builtin_bit_cast(float, __builtin_amdgcn_update_dpp(0, __builtin_bit_cast(int, v), CTRL, RMASK, 0xf, false)); }
__device__ __forceinline__ float row16_sum(float v) {
    v += dpp_<0xb1, 0xf>(v); v += dpp_<0x4e, 0xf>(v); v += dpp_<0x124, 0xf>(v); v += dpp_<0x128, 0xf>(v); return v; }
__device__ __forceinline__ float wave_sum(float v) {
    v = row16_sum(v); v += dpp_<0x142, 0xa>(v); v += dpp_<0x143, 0xc>(v);
    return __builtin_bit_cast(float, __builtin_amdgcn_readlane(__builtin_bit_cast(int, v), 63)); }
__device__ __forceinline__ float sigmoidf_(float x) { return 1.f / (1.f + __expf(-x)); }
__device__ __forceinline__ float siluf_(float x) { return x / (1.f + __expf(-x)); }
__device__ __forceinline__ int chunk_row0(int b, int cs) { return cs < 4 ? MLAT + b * CTXL + cs * 64 : b * SEQ + (cs - 4) * 64; }

template <int K> __device__ __forceinline__ f32x4 mma_tile(const LAS bf16_t* A, int lda, const LAS bf16_t* Bt, int ldb, f32x4 acc, int r, int q) {
#pragma unroll
    for (int k0 = 0; k0 < K; k0 += 32) {
        const bf16x8 a = *(const LAS bf16x8*)(A + r * lda + k0 + q * 8);
        const bf16x8 b = *(const LAS bf16x8*)(Bt + r * ldb + k0 + q * 8);
        acc = __builtin_amdgcn_mfma_f32_16x16x32_bf16(a, b, acc, 0, 0, 0);
    }
    return acc;
}

__device__ __forceinline__ void mod_phase(const Params& p, LAS unsigned char* lds, int bid, int nb) {
    LAS float* sc = (LAS float*)lds;
    LAS float* red = sc + 3072;
    const int tid = vopaque((int)threadIdx.x);
    for (int i = tid; i < 3072; i += 512) { const int s = i >> 10, k = i & 1023; const float v = s < 2 ? p.in[opaque(1)][s * 1024 + k] : p.in[opaque(3)][k]; sc[i] = siluf_(v); }
    __syncthreads();
    const int col = tid & 63, kg = tid >> 6;
    float* modo = (float*)(p.ws + (unsigned)opaque((int)WS_MOD));
    for (int it = bid; it < 192; it += nb) {
        const int l = it / 96, c0 = (it % 96) * 64;
        const float* W = p.in[opaque(4)] + (size_t)l * D * 6144 + c0 + col;
        float a0 = 0.f, a1 = 0.f, a2 = 0.f;
#pragma unroll 32
        for (int k = kg * 128; k < kg * 128 + 128; ++k) { const float w = W[(size_t)k * 6144]; a0 += sc[k] * w; a1 += sc[1024 + k] * w; a2 += sc[2048 + k] * w; }
        red[(kg * 3 + 0) * 64 + col] = a0; red[(kg * 3 + 1) * 64 + col] = a1; red[(kg * 3 + 2) * 64 + col] = a2;
        __syncthreads();
        if (tid < 192) { const int s = tid >> 6; float t = 0.f;
#pragma unroll
            for (int g = 0; g < 8; ++g) t += red[(g * 3 + s) * 64 + col];
            modo[(l * 3 + s) * 6144 + c0 + col] = t + p.in[opaque(5)][l * 6144 + c0 + col]; }
        __syncthreads();
    }
}

__device__ __forceinline__ void wt_item(const float* src, int ldw, bool zero, bf16_t* dst, int K, LAS float* scr, int lane) {
    float tv[32];
#pragma unroll
    for (int i = 0; i < 32; ++i) { const int kk = 2 * i + (lane >> 5); tv[i] = zero ? 0.f : src[(size_t)kk * ldw + (lane & 31)]; }
#pragma unroll
    for (int i = 0; i < 32; ++i) { const int kk = 2 * i + (lane >> 5); scr[kk * 33 + (lane & 31)] = tv[i]; }
    asm volatile("s_waitcnt lgkmcnt(0)" ::: "memory");
    const int c = lane & 7;
#pragma unroll
    for (int j = 0; j < 4; ++j) { const int n = (lane >> 3) + 8 * j; const LAS float* s = scr + (8 * c) * 33 + n;
        u32x4 o; o.x = pk2(s[0], s[33]); o.y = pk2(s[66], s[99]); o.z = pk2(s[132], s[165]); o.w = pk2(s[198], s[231]);
        *(u32x4*)(dst + (size_t)n * K + 8 * c) = o; }
    asm volatile("s_waitcnt lgkmcnt(0)" ::: "memory");
}
__device__ __forceinline__ void wconv_items(const Params& p, int l, int set, LAS unsigned char* lds, int bid, int G) {
    unsigned char* ws = p.ws; const int tid = vopaque((int)threadIdx.x), lane = tid & 63, wv = tid >> 6, gw = bid * 8 + wv, ngw = G * 8; LAS float* scr = (LAS float*)(lds + wv * 8448);
    if (set == 0) {
        const float* W = p.in[opaque(10)] + (size_t)l * D * INW;
        for (int it = gw; it < 120 * 16; it += ngw) { const int kb = it / 120, nb = it % 120;
            wt_item(W + (size_t)(kb * 64) * INW + nb * 32, INW, nb * 32 >= INW, (bf16_t*)(ws + WS_WIN) + (size_t)(nb * 32) * D + kb * 64, D, scr, lane); }
    } else {
        for (int it = gw + (set == 2 ? 512 : 0); it < (set == 2 ? 512 + 2816 + 1408 : 512); it += ngw) {
            int r = it;
            if (r < 512) { const int kb = r / 32, nb = r % 32;
                wt_item(p.in[opaque(30)] + (size_t)l * D * D + (size_t)(kb * 64) * D + nb * 32, D, false, (bf16_t*)(ws + WS_WOUT) + (size_t)(nb * 32) * D + kb * 64, D, scr, lane); continue; }
            r -= 512;
            if (r < 2816) { const int kb = r / 176, nb = r % 176; const int n0 = nb * 32, tile = n0 >> 8, within = n0 & 255, hid = tile * 128 + (within & 127);
                const float* W = (within < 128 ? p.in[opaque(31)] : p.in[opaque(32)]) + (size_t)l * D * FF;
                wt_item(W + (size_t)(kb * 64) * FF + hid, FF, false, (bf16_t*)(ws + WS_WGU) + (size_t)n0 * D + kb * 64, D, scr, lane); continue; }
            r -= 2816;
            { const int kb = r / 32, nb = r % 32;
                wt_item(p.in[opaque(33)] + (size_t)l * FF * D + (size_t)(kb * 64) * D + nb * 32, D, false, (bf16_t*)(ws + WS_WDN) + (size_t)(nb * 32) * FF + kb * 64, FF, scr, lane); }
        }
    }
}

__device__ __forceinline__ void row_phase(const float* res_lat, const float* res_ctx, const bf16_t* Cm, const float* gpost, const float* modg, int gate_off,
                                          float* dst_lat, float* dst_ctx, const float* gpre, const float* modn, int sh_off, int sc_off, bf16_t* xn, int M, int bid, int G, const float* part = nullptr, int npart = 0) {
    const int tid = vopaque((int)threadIdx.x), lane = tid & 63, gw = bid * 8 + (tid >> 6), ngw = G * 8;
    f32x4 nv[4], nc[4];
#define RP_LOAD(mm) do { const int m_ = (mm); const float* rr_ = m_ >= MLAT ? res_ctx + (size_t)(m_ - MLAT) * D : res_lat + (size_t)m_ * D; \
        _Pragma("unroll") for (int j = 0; j < 4; ++j) { nv[j] = *(const f32x4*)(rr_ + j * 256 + lane * 4); \
            if (Cm) { if (npart > 0 && m_ >= MLAT) { f32x4 t_ = {0.f, 0.f, 0.f, 0.f}; for (int k_ = 0; k_ < npart; ++k_) t_ = t_ + *(const f32x4*)(part + ((size_t)k_ * MCTX + (m_ - MLAT)) * D + j * 256 + lane * 4); nc[j] = t_; } \
                      else { const u32x2 c_ = *(const u32x2*)(Cm + (size_t)m_ * D + j * 256 + lane * 4); nc[j] = (f32x4){__uint_as_float(c_.x << 16), __uint_as_float(c_.x & 0xffff0000u), __uint_as_float(c_.y << 16), __uint_as_float(c_.y & 0xffff0000u)}; } } } } while (0)
    if (gw < M) RP_LOAD(gw);
    for (int m = gw; m < M; m += ngw) {
        const bool isctx = m >= MLAT; const int ms = isctx ? 2 : (m >> 13);
        f32x4 v[4], c[4];
#pragma unroll
        for (int j = 0; j < 4; ++j) { v[j] = nv[j]; c[j] = nc[j]; }
        if (m + ngw < M) RP_LOAD(m + ngw);
        if (Cm) {
            f32x4 gp[4], gt[4]; float ss = 0.f;
#pragma unroll
            for (int j = 0; j < 4; ++j) { const int col = j * 256 + lane * 4; gp[j] = *(const f32x4*)(gpost + col); gt[j] = *(const f32x4*)(modg + ms * 6144 + gate_off + col);
                ss += c[j][0] * c[j][0] + c[j][1] * c[j][1] + c[j][2] * c[j][2] + c[j][3] * c[j][3]; }
            ss = wave_sum(ss); const float rstd = rsqrtf(ss * (1.f / 1024.f) + 1e-6f);
#pragma unroll
            for (int j = 0; j < 4; ++j) v[j] = v[j] + gt[j] * (c[j] * rstd * gp[j]);
        }
        if (dst_lat) { float* drow = isctx ? dst_ctx + (size_t)(m - MLAT) * D : dst_lat + (size_t)m * D;
#pragma unroll
            for (int j = 0; j < 4; ++j) *(f32x4*)(drow + j * 256 + lane * 4) = v[j]; }
        if (xn) {
            f32x4 gp[4], sh[4], sc[4]; float ss = 0.f;
#pragma unroll
            for (int j = 0; j < 4; ++j) { const int col = j * 256 + lane * 4; gp[j] = *(const f32x4*)(gpre + col); sh[j] = *(const f32x4*)(modn + ms * 6144 + sh_off + col); sc[j] = *(const f32x4*)(modn + ms * 6144 + sc_off + col);
                ss += v[j][0] * v[j][0] + v[j][1] * v[j][1] + v[j][2] * v[j][2] + v[j][3] * v[j][3]; }
            ss = wave_sum(ss); const float rstd = rsqrtf(ss * (1.f / 1024.f) + 1e-6f);
#pragma unroll
            for (int j = 0; j < 4; ++j) { const int col = j * 256 + lane * 4; const f32x4 y = (v[j] * rstd * gp[j]) * (sc[j] + 1.f) + sh[j];
                u32x2 o; o.x = pk2(y[0], y[1]); o.y = pk2(y[2], y[3]); *(u32x2*)(xn + (size_t)m * D + col) = o; }
        }
    }
#undef RP_LOAD
}

constexpr int LP = 72;
#define LBAR() do { asm volatile("s_waitcnt lgkmcnt(0)" ::: "memory"); __builtin_amdgcn_s_barrier(); asm volatile("" ::: "memory"); } while (0)
__device__ __forceinline__ float logsig_(float z) { return fminf(z, 0.f) - __logf(1.f + __expf(-fabsf(z))); }
__device__ __forceinline__ void la_item(const Params& p, int l, int idx, int pass, bool last, LAS unsigned char* lds) {
    const int tid = vopaque((int)threadIdx.x), lane = tid & 63, w = tid >> 6, r = lane & 15, q = lane >> 4;
    const int kind = idx / 1056, rem = idx % 1056, b = rem / 528, rem2 = rem % 528, cs = rem2 >> 2, h = rem2 & 3;
    if (pass == 3 && last && cs < 4) return;
    const int DK = kind ? 48 : 64, DV = kind ? 96 : 64;
    const int qoff = kind ? 1024 + 48 * h : 64 * h, koff = kind ? 1216 + 48 * h : 256 + 64 * h, voff = kind ? 1408 + 96 * h : 512 + 64 * h, goff = kind ? 1792 + 96 * h : 768 + 64 * h;
    const int ycol = kind ? 256 + 96 * h : 64 * h;
    const int row0 = chunk_row0(b, cs);
    const int chain = ((kind * 2 + b) * 4 + h) * 2;
    const bf16_t* U = (const bf16_t*)(p.ws + (unsigned)opaque((int)WS_U));
    bf16_t* Y = (bf16_t*)(p.ws + (unsigned)opaque((int)WS_Y));
    bf16_t* Sf = kind ? (bf16_t*)(p.ws + (unsigned)opaque((int)WS_SGLA)) + ((size_t)(chain - 16) * NCH + cs) * 4608 : (bf16_t*)(p.ws + (unsigned)opaque((int)WS_SRET)) + ((size_t)chain * NCH + cs) * 4096;
    bf16_t* Sb = Sf + (size_t)NCH * (kind ? 4608 : 4096);
    float* dec = (float*)(p.ws + (unsigned)opaque((int)WS_DEC)) + ((size_t)chain * NCH + cs) * 64;
    LAS float* cumf = (LAS float*)lds; LAS float* cumb = cumf + 4096;
    LAS bf16_t* QF = (LAS bf16_t*)(lds + 32768); LAS bf16_t* QB = QF + 64 * LP; LAS bf16_t* KF = QB + 64 * LP; LAS bf16_t* KB = KF + 64 * LP;
    LAS bf16_t* VT = KB + 64 * LP; LAS bf16_t* PF = VT + 96 * LP; LAS bf16_t* PB = PF + 64 * LP; LAS bf16_t* STF = PB + 64 * LP; LAS bf16_t* STB = STF + 96 * LP;
    LAS float* red = (LAS float*)(STB + 96 * LP);
    if (kind == 0) {
        const float lgf = logf(1.f - exp2f(-5.f - (float)h)), lgb = logf(1.f - exp2f(-5.f - (float)(3 - h)));
        for (int e = tid; e < 4096; e += 512) { const int i = e >> 6; cumf[e] = (float)(i + 1) * lgf; cumb[e] = (float)(64 - i) * lgb; }
    } else {
        const float* wa2f = p.in[opaque(12)] + l * 16 * 192 + h * 48; const float* baf = p.in[opaque(13)] + l * 192 + h * 48;
        const float* wa2b = p.in[opaque(14)] + l * 16 * 192 + h * 48; const float* bab = p.in[opaque(15)] + l * 192 + h * 48;
        LAS bf16_t* LR = (LAS bf16_t*)(lds + 32768); LAS bf16_t* WtF = LR + 64 * 40; LAS bf16_t* WtB = WtF + 48 * 40; LAS float* SEG = (LAS float*)(WtB + 48 * 40);
        if (tid < 256) { const int i = tid >> 2, ch = tid & 3; *(LAS u32x4*)(LR + i * 40 + ch * 8) = *(const u32x4*)(U + (size_t)(row0 + i) * NU + 2176 + ch * 8); }
        for (int e = tid; e < 48 * 32; e += 512) { const int d = e % 48, k = e / 48; WtF[d * 40 + k] = k < 16 ? f2bf(wa2f[k * 192 + d]) : (bf16_t)0; WtB[d * 40 + k] = k >= 16 ? f2bf(wa2b[(k - 16) * 192 + d]) : (bf16_t)0; }
        for (int e = tid; e < 64 * 16; e += 512) { const int i = e >> 4, d = 48 + (e & 15); cumf[i * 64 + d] = 0.f; cumb[i * 64 + d] = 0.f; }
        LBAR();
        { const int dirA = w >> 2, mtA = w & 3; const LAS bf16_t* Wt = dirA ? WtB : WtF; LAS float* cu = dirA ? cumb : cumf; const float* bia = dirA ? bab : baf;
#pragma unroll
          for (int nt = 0; nt < 3; ++nt) { f32x4 a = {0.f, 0.f, 0.f, 0.f}; a = mma_tile<32>(LR + mtA * 16 * 40, 40, Wt + nt * 16 * 40, 40, a, r, q); const float bz = bia[nt * 16 + r];
#pragma unroll
              for (int j = 0; j < 4; ++j) cu[(mtA * 16 + q * 4 + j) * 64 + nt * 16 + r] = logsig_(a[j] + bz) * 0.0625f; } }
        LBAR();
        { const int d = tid & 63, sg = tid >> 6; float vf[8], vb[8]; float rf = 0.f, rb = 0.f;
#pragma unroll
          for (int j = 0; j < 8; ++j) { rf += cumf[(sg * 8 + j) * 64 + d]; vf[j] = rf; }
#pragma unroll
          for (int j = 7; j >= 0; --j) { rb += cumb[(sg * 8 + j) * 64 + d]; vb[j] = rb; }
          SEG[sg * 64 + d] = rf; SEG[512 + sg * 64 + d] = rb;
          LBAR();
          float of = 0.f, ob = 0.f;
#pragma unroll
          for (int g = 0; g < 8; ++g) { if (g < sg) of += SEG[g * 64 + d]; if (g > sg) ob += SEG[512 + g * 64 + d]; }
#pragma unroll
          for (int j = 0; j < 8; ++j) { cumf[(sg * 8 + j) * 64 + d] = vf[j] + of; cumb[(sg * 8 + j) * 64 + d] = vb[j] + ob; } }
    }
    LBAR();
    const bool rope = (kind == 0) && (cs >= 4);
    const float qs = kind ? 0.14433756729740643f : 1.f, ks = kind ? 1.f : 0.125f;
    for (int e = tid; e < 2048; e += 512) {
        const int i = e >> 5, pp = e & 31, d1 = pp < 16 ? pp : pp + 16, d2 = d1 + 16;
        const bf16_t* ur = U + (size_t)(row0 + i) * NU;
        float q1 = d1 < DK ? bf2f(ur[qoff + d1]) : 0.f, q2 = d2 < DK ? bf2f(ur[qoff + d2]) : 0.f;
        float k1 = d1 < DK ? bf2f(ur[koff + d1]) : 0.f, k2 = d2 < DK ? bf2f(ur[koff + d2]) : 0.f;
        if (rope) { const float pos = pp < 16 ? (float)(cs - 4) : (float)i; const float ang = pos * exp2f(-(float)(pp & 15) * 0.8304820237218406f);
            const float sn = __sinf(ang), cn = __cosf(ang);
            const float a = q1 * cn - q2 * sn, bq = q1 * sn + q2 * cn, c = k1 * cn - k2 * sn, dk_ = k1 * sn + k2 * cn; q1 = a; q2 = bq; k1 = c; k2 = dk_; }
        q1 *= qs; q2 *= qs; k1 *= ks; k2 *= ks;
        const float cf1 = cumf[i * 64 + d1], cf2 = cumf[i * 64 + d2], cb1 = cumb[i * 64 + d1], cb2 = cumb[i * 64 + d2];
        if (pass == 3) {
            QF[i * LP + d1] = f2bf(q1 * __expf(cf1)); QF[i * LP + d2] = f2bf(q2 * __expf(cf2));
            QB[i * LP + d1] = f2bf(q1 * __expf(cb1)); QB[i * LP + d2] = f2bf(q2 * __expf(cb2));
            KF[i * LP + d1] = f2bf(k1 * __expf(-cf1)); KF[i * LP + d2] = f2bf(k2 * __expf(-cf2));
            KB[i * LP + d1] = f2bf(k1 * __expf(-cb1)); KB[i * LP + d2] = f2bf(k2 * __expf(-cb2));
        } else {
            const float ef1 = cumf[63 * 64 + d1], ef2 = cumf[63 * 64 + d2], eb1 = cumb[d1], eb2 = cumb[d2];
            KF[d1 * LP + i] = f2bf(k1 * __expf(ef1 - cf1)); KF[d2 * LP + i] = f2bf(k2 * __expf(ef2 - cf2));
            KB[d1 * LP + i] = f2bf(k1 * __expf(eb1 - cb1)); KB[d2 * LP + i] = f2bf(k2 * __expf(eb2 - cb2));
        }
    }
    { const int nvb = DV >> 3;
      for (int e = tid; e < 64 * nvb; e += 512) { const int j = e / nvb, vb = e % nvb;
          const bf16x8 vv = *(const bf16x8*)(U + (size_t)(row0 + j) * NU + voff + vb * 8);
#pragma unroll
          for (int t = 0; t < 8; ++t) VT[(vb * 8 + t) * LP + j] = (bf16_t)vv[t]; } }
    if (pass == 1) {
        LBAR();
        const int dir = w >> 2, nt = w & 3; const LAS bf16_t* KH = dir ? KB : KF; bf16_t* So = dir ? Sb : Sf; const int d = nt * 16 + r;
        for (int mt = 0; mt < (DV >> 4); ++mt) { f32x4 acc = {0.f, 0.f, 0.f, 0.f}; acc = mma_tile<64>(VT + mt * 16 * LP, LP, KH + nt * 16 * LP, LP, acc, r, q);
            if (d < DK) {
#pragma unroll
                for (int j = 0; j < 4; ++j) So[(mt * 16 + q * 4 + j) * DK + d] = f2bf(acc[j]); } }
        if (tid < 64) dec[tid] = cumf[63 * 64 + tid]; else if (tid < 128) dec[NCH * 64 + tid - 64] = cumb[tid - 64];
        LBAR();
        return;
    }
    for (int e = tid; e < DV * 8; e += 512) { const int v = e >> 3, db = e & 7; u32x4 zf = {0u, 0u, 0u, 0u}, zb = zf;
        if (db * 8 < DK) { zf = *(const u32x4*)(Sf + v * DK + db * 8); zb = *(const u32x4*)(Sb + v * DK + db * 8); }
        *(LAS u32x4*)(STF + v * LP + db * 8) = zf; *(LAS u32x4*)(STB + v * LP + db * 8) = zb; }
    LBAR();
    { const int dir = w >> 2, rb = w & 3; const LAS bf16_t* Qd = dir ? QB : QF; const LAS bf16_t* Kd = dir ? KB : KF; LAS bf16_t* Pd = dir ? PB : PF;
#pragma unroll
      for (int nt = 0; nt < 4; ++nt) { f32x4 acc = {0.f, 0.f, 0.f, 0.f}; acc = mma_tile<64>(Qd + rb * 16 * LP, LP, Kd + nt * 16 * LP, LP, acc, r, q);
#pragma unroll
          for (int j = 0; j < 4; ++j) { const int i = rb * 16 + q * 4 + j, jj = nt * 16 + r; const bool keep = dir ? (jj >= i) : (jj <= i); Pd[i * LP + jj] = f2bf(keep ? acc[j] : 0.f); } } }
    LBAR();
    const int rb = w & 3, ch = w >> 2, NT = DV >> 5;
    f32x4 acc[3];
#pragma unroll
    for (int nt = 0; nt < 3; ++nt) { acc[nt] = (f32x4){0.f, 0.f, 0.f, 0.f};
        if (nt < NT) { const int v0 = (ch * NT + nt) * 16;
            acc[nt] = mma_tile<64>(PF + rb * 16 * LP, LP, VT + v0 * LP, LP, acc[nt], r, q);
            acc[nt] = mma_tile<64>(PB + rb * 16 * LP, LP, VT + v0 * LP, LP, acc[nt], r, q);
            acc[nt] = mma_tile<64>(QF + rb * 16 * LP, LP, STF + v0 * LP, LP, acc[nt], r, q);
            acc[nt] = mma_tile<64>(QB + rb * 16 * LP, LP, STB + v0 * LP, LP, acc[nt], r, q); } }
    float s1[4], s2[4];
#pragma unroll
    for (int j = 0; j < 4; ++j) { s1[j] = acc[0][j] + acc[1][j] + acc[2][j]; s2[j] = acc[0][j] * acc[0][j] + acc[1][j] * acc[1][j] + acc[2][j] * acc[2][j];
        s1[j] = row16_sum(s1[j]); s2[j] = row16_sum(s2[j]); }
    if (r == 0) {
#pragma unroll
        for (int j = 0; j < 4; ++j) { red[((rb * 2 + ch) * 16 + q * 4 + j) * 2] = s1[j]; red[((rb * 2 + ch) * 16 + q * 4 + j) * 2 + 1] = s2[j]; } }
    LBAR();
    const float invdv = 1.f / (float)DV;
#pragma unroll
    for (int j = 0; j < 4; ++j) { const int rr = q * 4 + j;
        const float t1 = red[((rb * 2) * 16 + rr) * 2] + red[((rb * 2 + 1) * 16 + rr) * 2], t2 = red[((rb * 2) * 16 + rr) * 2 + 1] + red[((rb * 2 + 1) * 16 + rr) * 2 + 1];
        const float mean = t1 * invdv; float mu, rstd;
        if (kind == 0) { mu = mean; rstd = rsqrtf(fmaxf(t2 * invdv - mean * mean, 0.f) + 1e-5f); } else { mu = 0.f; rstd = rsqrtf(t2 * invdv + 1e-5f); }
        const int row = row0 + rb * 16 + rr;
#pragma unroll
        for (int nt = 0; nt < 3; ++nt) if (nt < NT) { const int v = (ch * NT + nt) * 16 + r;
            const float nw = kind ? p.in[opaque(16)][l * 96 + v] : p.in[opaque(11)][l * 256 + h * 64 + v];
            const float g = bf2f(U[(size_t)row * NU + goff + v]);
            Y[(size_t)row * D + ycol + v] = f2bf((acc[nt][j] - mu) * rstd * nw * siluf_(g)); } }
    LBAR();
}

__device__ __forceinline__ void la_scan(const Params& p, int vb, int nvb) {
    typedef float f32x2s __attribute__((ext_vector_type(2)));
    for (int e2 = vb * 512 + vopaque((int)threadIdx.x); e2 < 32 * 2304; e2 += nvb * 512) {
        const int chain = e2 / 2304, el = (e2 % 2304) * 2, kind = chain >> 4, dir = chain & 1;
        if (kind == 0 && el >= 4096) continue;
        const int DK = kind ? 48 : 64, d = el % DK, esz2 = kind ? 2304 : 2048;
        unsigned* S = (unsigned*)((kind ? (bf16_t*)(p.ws + (unsigned)opaque((int)WS_SGLA)) + (size_t)(chain - 16) * NCH * 4608 : (bf16_t*)(p.ws + (unsigned)opaque((int)WS_SRET)) + (size_t)chain * NCH * 4096) + el);
        const float* dec = (const float*)(p.ws + (unsigned)opaque((int)WS_DEC)) + (size_t)chain * NCH * 64 + d;
        float a0 = 0.f, a1 = 0.f;
        for (int s = 0; s < NCH; s += 12) {
            int sl[12]; unsigned t[12]; f32x2s dc[12];
#pragma unroll
            for (int u = 0; u < 12; ++u) { const int ss = s + u; sl[u] = dir ? (ss < 4 ? 3 - ss : 135 - ss) : ss; t[u] = S[(size_t)sl[u] * esz2]; dc[u] = *(const f32x2s*)(dec + sl[u] * 64); }
#pragma unroll
            for (int u = 0; u < 12; ++u) { S[(size_t)sl[u] * esz2] = pk2(a0, a1); a0 = a0 * __expf(dc[u].x) + __uint_as_float(t[u] << 16); a1 = a1 * __expf(dc[u].y) + __uint_as_float(t[u] & 0xffff0000u); }
        }
    }
}

__device__ __forceinline__ float rw_conv(const bf16_t* U, const float* cw, int row, int t, int tmax, int col) {
    const bf16_t* uc = U + (size_t)row * NU + 2208 + col; float x = cw[1472 + col] * bf2f(uc[0]);
    if (t > 0) x += cw[col] * bf2f(uc[-NU]);
    if (t + 1 < tmax) x += cw[2944 + col] * bf2f(uc[NU]);
    return x;
}
__device__ __forceinline__ float lwdec_(float z) { const float sp = (-z > 20.f) ? -z : __logf(1.f + __expf(-z)); return -__expf(-sp - 0.5f); }
__device__ __forceinline__ float tanh_(float x) { return 1.f - 2.f / (__expf(2.f * x) + 1.f); }
__device__ __forceinline__ u32x2 pack4(const f32x4 a) { u32x2 o; o.x = pk2(a[0], a[1]); o.y = pk2(a[2], a[3]); return o; }
__device__ __forceinline__ f32x4 unpack4(const u32x2 v) { f32x4 a; a[0] = __uint_as_float(v.x << 16); a[1] = __uint_as_float(v.x & 0xffff0000u); a[2] = __uint_as_float(v.y << 16); a[3] = __uint_as_float(v.y & 0xffff0000u); return a; }

typedef _Float16 half8_t __attribute__((ext_vector_type(8)));
typedef _Float16 half2_t __attribute__((ext_vector_type(2)));
__device__ __forceinline__ float clamph(float x) { return fminf(fmaxf(x, -60000.f), 60000.f); }
__device__ __forceinline__ bf16_t f2h(float f);
__device__ __forceinline__ unsigned pk2h(float lo, float hi) { return (unsigned)f2h(lo) | ((unsigned)f2h(hi) << 16); }
__device__ __forceinline__ bf16_t f2h(float f) { return __builtin_bit_cast(unsigned short, (_Float16)f); }
__device__ __forceinline__ u32x2 pack4h(const f32x4 a) { u32x2 o; o.x = pk2h(a[0], a[1]); o.y = pk2h(a[2], a[3]); return o; }
__device__ __forceinline__ float h2f_(unsigned short b) { return (float)__builtin_bit_cast(_Float16, b); }
__device__ __forceinline__ f32x4 unpack4h(const u32x2 v) { f32x4 a; a[0] = h2f_((unsigned short)(v.x & 0xffffu)); a[1] = h2f_((unsigned short)(v.x >> 16)); a[2] = h2f_((unsigned short)(v.y & 0xffffu)); a[3] = h2f_((unsigned short)(v.y >> 16)); return a; }
__device__ __forceinline__ float expc_(float x) { return __expf(fminf(x, 8.f)); }
template <int K> __device__ __forceinline__ f32x4 mma_tile_h(const LAS bf16_t* A, int lda, const LAS bf16_t* Bt, int ldb, f32x4 acc, int r, int q) {
#pragma unroll
    for (int k0 = 0; k0 < K; k0 += 32) {
        const bf16x8 a = *(const LAS bf16x8*)(A + r * lda + k0 + q * 8);
        const bf16x8 b = *(const LAS bf16x8*)(Bt + r * ldb + k0 + q * 8);
        acc = __builtin_amdgcn_mfma_f32_16x16x32_f16(__builtin_bit_cast(half8_t, a), __builtin_bit_cast(half8_t, b), acc, 0, 0, 0);
    }
    return acc;
}
__device__ __forceinline__ void w2t_phase(const Params& p, int l, int bid, int G) {
    bf16_t* o = (bf16_t*)(p.ws + (unsigned)opaque((int)WS_W2T));
    for (int e = bid * 512 + vopaque((int)threadIdx.x); e < 6 * 20480; e += G * 512) { const int h = e / 20480, x = e % 20480; float v;
        if (x < 12288) { const int which = x >> 12, hd = (x >> 6) & 63, rr = x & 63; const float* src = which == 0 ? p.in[opaque(23)] : which == 1 ? p.in[opaque(19)] : p.in[opaque(21)]; v = src[(size_t)l * 64 * 384 + rr * 384 + h * 64 + hd]; }
        else { const int y = x - 12288, hd = y >> 7, rr = y & 127; v = p.in[opaque(24)][(size_t)l * 128 * 384 + rr * 384 + h * 64 + hd]; }
        o[e] = f2h(v); }
}

__device__ __forceinline__ void lr_pre_phase(const Params& p, int l, int bid, int G) {
    bf16_t* U = (bf16_t*)(p.ws + (unsigned)opaque((int)WS_U)); bf16_t* ACT = (bf16_t*)(p.ws + (unsigned)opaque((int)WS_ACT));
    const float* cw = p.in[opaque(17)] + l * 3 * 1472;
    for (int e = bid * 512 + vopaque((int)threadIdx.x); e < MALL * 40; e += G * 512) { const int m = e / 40, c0 = (e % 40) * 8, col = 1152 + c0;
        const int t = m < MLAT ? (m & (SEQ - 1)) : ((m - MLAT) & (CTXL - 1)), tmax = m < MLAT ? SEQ : CTXL;
        const bf16_t* uc = U + (size_t)m * NU + 2208 + col;
        const bf16x8 zz = {0, 0, 0, 0, 0, 0, 0, 0};
        const bf16x8 u0 = *(const bf16x8*)uc, um = (t > 0) ? *(const bf16x8*)(uc - NU) : zz, up = (t + 1 < tmax) ? *(const bf16x8*)(uc + NU) : zz;
        float x[8];
#pragma unroll
        for (int hh = 0; hh < 2; ++hh) { const f32x4 wm = *(const f32x4*)(cw + col + 4 * hh), w0 = *(const f32x4*)(cw + 1472 + col + 4 * hh), wp = *(const f32x4*)(cw + 2944 + col + 4 * hh);
#pragma unroll
            for (int j = 0; j < 4; ++j) x[4 * hh + j] = wm[j] * bf2f((bf16_t)um[4 * hh + j]) + w0[j] * bf2f((bf16_t)u0[4 * hh + j]) + wp[j] * bf2f((bf16_t)up[4 * hh + j]); }
        if (c0 < 128) {
#pragma unroll
            for (int j = 0; j < 8; ++j) x[j] = tanh_(x[j]); }
        else if (c0 >= 192) {
#pragma unroll
            for (int j = 0; j < 8; ++j) x[j] = sigmoidf_(x[j]); }
        u32x4 o; o.x = pk2h(x[0], x[1]); o.y = pk2h(x[2], x[3]); o.z = pk2h(x[4], x[5]); o.w = pk2h(x[6], x[7]);
        bf16_t* dst = c0 < 128 ? U + (size_t)m * NU + 3680 + c0 : ACT + (size_t)m * 192 + c0 - 128;
        *(u32x4*)dst = o; }
}

__device__ __forceinline__ void ldfrag2(const LAS bf16_t* M, int row0, int r, int q, bf16x8 (&f)[2]) { f[0] = *(const LAS bf16x8*)(M + (row0 + r) * LP + q * 8); f[1] = *(const LAS bf16x8*)(M + (row0 + r) * LP + 32 + q * 8); }
__device__ __forceinline__ f32x4 mm2h(const bf16x8 (&a)[2], const bf16x8 (&b)[2], f32x4 acc) {
    acc = __builtin_amdgcn_mfma_f32_16x16x32_f16(__builtin_bit_cast(half8_t, a[0]), __builtin_bit_cast(half8_t, b[0]), acc, 0, 0, 0);
    acc = __builtin_amdgcn_mfma_f32_16x16x32_f16(__builtin_bit_cast(half8_t, a[1]), __builtin_bit_cast(half8_t, b[1]), acc, 0, 0, 0); return acc; }
constexpr int SLB = 9216;
#define SLOT(n) ((LAS bf16_t*)(lds + (n) * SLB))
template <bool PC> __device__ __forceinline__ void rw_item(const Params& p, int l, int idx, bool last, LAS unsigned char* lds) {
    const int tid = vopaque((int)threadIdx.x), lane = tid & 63, w = tid >> 6, r = lane & 15, q = lane >> 4;
    const int b = idx / 792, rem = idx % 792, cs = rem / 6, h = rem % 6;
    if (PC && last && cs < 4) return;
    const int row0 = chunk_row0(b, cs), t0 = cs < 4 ? cs * 64 : (cs - 4) * 64, tmax = cs < 4 ? CTXL : SEQ;
    const bf16_t* U = (const bf16_t*)(p.ws + (unsigned)opaque((int)WS_U));
    const float* cw = p.in[opaque(17)] + l * 3 * 1472;
    float ur[10], uk[10], uv[10];
#pragma unroll
    for (int jr = 0; jr < 10; ++jr) { const int i = w * 8 + jr - 1, t = t0 + i; const bool ok = (t >= 0) && (t < tmax);
        const bf16_t* up_ = U + (size_t)(row0 + (ok ? i : 0)) * NU + 2208 + h * 64 + lane;
        const bf16_t x0 = up_[0], x1 = up_[384], x2 = up_[768];
        ur[jr] = ok ? bf2f(x0) : 0.f; uk[jr] = ok ? bf2f(x1) : 0.f; uv[jr] = ok ? bf2f(x2) : 0.f; }
    const int hc = l * 384 + h * 64 + lane;
    const float a0v = p.in[opaque(22)][hc], w0fv = p.in[opaque(18)][hc], w0bv = p.in[opaque(20)][hc], kkv = p.in[opaque(25)][hc], kav = p.in[opaque(26)][hc], rkv = p.in[opaque(27)][hc];
    u32x4 hv0 = {0u, 0u, 0u, 0u}, hv1 = hv0;
    if (PC) { const bf16_t* Nb = (const bf16_t*)(p.ws + (unsigned)opaque((int)WS_RWN)) + ((size_t)((b * 6 + h) * 2) * NCH + cs) * 4096 + (tid >> 3) * 64 + (tid & 7) * 8;
        hv0 = *(const u32x4*)Nb; hv1 = *(const u32x4*)(Nb + (size_t)NCH * 4096); }
    LAS float* ZA = (LAS float*)lds; LAS float* ZF = ZA + 4096; LAS float* ZB = ZF + 4096; LAS float* ZG = ZB + 4096;
    LAS bf16_t* LAa = (LAS bf16_t*)(lds + 65536); LAS bf16_t* LWF = LAa + 64 * LP; LAS bf16_t* LWB = LWF + 64 * LP; LAS bf16_t* LGs = LWB + 64 * LP;
    LAS bf16_t* A2T = LGs + 64 * 136; LAS bf16_t* WFT = A2T + 64 * LP; LAS bf16_t* WBT = WFT + 64 * LP; LAS bf16_t* G2T = WBT + 64 * LP;
    { constexpr int NG = (PC ? 320 : 192) / 8;
      const bf16_t* ACT = (const bf16_t*)(p.ws + (unsigned)opaque((int)WS_ACT));
      for (int e = tid; e < 64 * NG; e += 512) { const int i = e / NG, c0 = (e % NG) * 8;
          const u32x4 v = c0 < 128 ? *(const u32x4*)(U + (size_t)(row0 + i) * NU + 3680 + c0) : *(const u32x4*)(ACT + (size_t)(row0 + i) * 192 + c0 - 128);
          LAS bf16_t* dst = c0 < 64 ? LWF + i * LP + c0 : c0 < 128 ? LWB + i * LP + c0 - 64 : c0 < 192 ? LAa + i * LP + c0 - 128 : LGs + i * 136 + c0 - 192;
          *(LAS u32x4*)dst = v; } }
    { const bf16_t* wt = (const bf16_t*)(p.ws + (unsigned)opaque((int)WS_W2T)) + (size_t)h * 20480; const int row = tid >> 3, ch = tid & 7;
      *(LAS u32x4*)(A2T + row * LP + ch * 8) = *(const u32x4*)(wt + row * 64 + ch * 8);
      *(LAS u32x4*)(WFT + row * LP + ch * 8) = *(const u32x4*)(wt + 4096 + row * 64 + ch * 8);
      *(LAS u32x4*)(WBT + row * LP + ch * 8) = *(const u32x4*)(wt + 8192 + row * 64 + ch * 8);
      if (PC) for (int e = tid; e < 1024; e += 512) { const int rw = e >> 4, c2 = e & 15; *(LAS u32x4*)(G2T + rw * 136 + c2 * 8) = *(const u32x4*)(wt + 12288 + rw * 128 + c2 * 8); } }
    LBAR();
#pragma unroll
    for (int tt = 0; tt < 2; ++tt) { const int t = w * 2 + tt, mt = t >> 2, nt = t & 3, o = (mt * 16 + q * 4) * 64 + nt * 16 + r;
        f32x4 a = {0.f, 0.f, 0.f, 0.f}; a = mma_tile_h<64>(LAa + mt * 16 * LP, LP, A2T + nt * 16 * LP, LP, a, r, q);
#pragma unroll
        for (int j = 0; j < 4; ++j) ZA[o + j * 64] = a[j];
        a = (f32x4){0.f, 0.f, 0.f, 0.f}; a = mma_tile_h<64>(LWF + mt * 16 * LP, LP, WFT + nt * 16 * LP, LP, a, r, q);
#pragma unroll
        for (int j = 0; j < 4; ++j) ZF[o + j * 64] = a[j];
        a = (f32x4){0.f, 0.f, 0.f, 0.f}; a = mma_tile_h<64>(LWB + mt * 16 * LP, LP, WBT + nt * 16 * LP, LP, a, r, q);
#pragma unroll
        for (int j = 0; j < 4; ++j) ZB[o + j * 64] = a[j];
        if (PC) { a = (f32x4){0.f, 0.f, 0.f, 0.f}; a = mma_tile_h<128>(LGs + mt * 16 * 136, 136, G2T + nt * 16 * 136, 136, a, r, q);
#pragma unroll
            for (int j = 0; j < 4; ++j) ZG[o + j * 64] = a[j]; } }
    LBAR();
    float R_[8], K2[8], V_[8], KN[8], BE[8], LF[8], LB[8], GG[8], BO[8];
    {
      const int cc = h * 64 + lane;
      const float cr0 = cw[cc], cr1 = cw[1472 + cc], cr2 = cw[2944 + cc], ck0 = cw[384 + cc], ck1 = cw[1472 + 384 + cc], ck2 = cw[2944 + 384 + cc], cv0 = cw[768 + cc], cv1 = cw[1472 + 768 + cc], cv2 = cw[2944 + 768 + cc];
#pragma unroll
      for (int jj = 0; jj < 8; ++jj) { const int i = w * 8 + jj;
          const float rv = cr0 * ur[jj] + cr1 * ur[jj + 1] + cr2 * ur[jj + 2], kv = ck0 * uk[jj] + ck1 * uk[jj + 1] + ck2 * uk[jj + 2], vv = cv0 * uv[jj] + cv1 * uv[jj + 1] + cv2 * uv[jj + 2];
          const float a = sigmoidf_(a0v + ZA[i * 64 + lane]);
          LF[jj] = lwdec_(w0fv + ZF[i * 64 + lane]); LB[jj] = lwdec_(w0bv + ZB[i * 64 + lane]);
          float kk = kv * kkv; const float n2 = wave_sum(kk * kk); kk *= rsqrtf(fmaxf(n2, 1e-24f));
          const float k2 = kv * (1.f + (a - 1.f) * kav);
          R_[jj] = rv; K2[jj] = k2; V_[jj] = vv; KN[jj] = kk; BE[jj] = kk * a;
          if (PC) { GG[jj] = ZG[i * 64 + lane]; BO[jj] = wave_sum(rv * k2 * rkv) * vv; } else { GG[jj] = 0.f; BO[jj] = 0.f; } } }
    LBAR();
    LAS float* TOT = (LAS float*)(lds + 17 * SLB);
    LAS bf16_t* AB = SLOT(0); LAS bf16_t* BBm = SLOT(1); LAS bf16_t* KBm = SLOT(2); LAS bf16_t* S3 = SLOT(3); LAS bf16_t* VT = SLOT(4); LAS bf16_t* S5 = SLOT(5);
    LAS bf16_t* XP = SLOT(6); LAS bf16_t* XPT = SLOT(7); LAS bf16_t* XST = SLOT(8); LAS bf16_t* YP = SLOT(9); LAS bf16_t* YPT = SLOT(10); LAS bf16_t* YST = SLOT(11);
    LAS bf16_t* AAK = SLOT(12); LAS bf16_t* ARB = SLOT(13); LAS bf16_t* ARK = SLOT(14);
    LAS bf16_t* XT = PC ? SLOT(15) : SLOT(13);
    LAS bf16_t* UT = PC ? SLOT(16) : SLOT(15);
    f32x4 Of[2] = {{0.f, 0.f, 0.f, 0.f}, {0.f, 0.f, 0.f, 0.f}};
    const int mtw = w >> 1, ntw = (w & 1) * 2;
    for (int dir = 0; dir < 2; ++dir) {
        const int cd = ((b * 6 + h) * 2 + dir) * NCH + cs;
        bf16_t* Mg = (bf16_t*)(p.ws + (unsigned)opaque((int)WS_RWM)) + (size_t)cd * 4096; bf16_t* Ng = (bf16_t*)(p.ws + (unsigned)opaque((int)WS_RWN)) + (size_t)cd * 4096; float* Pg = (float*)(p.ws + (unsigned)opaque((int)WS_RWP)) + (size_t)cd * 64;
        float cum[8]; float run = 0.f;
        if (dir == 0) {
#pragma unroll
            for (int jj = 0; jj < 8; ++jj) { run += LF[jj]; cum[jj] = run; } }
        else {
#pragma unroll
            for (int jj = 7; jj >= 0; --jj) { run += LB[jj]; cum[jj] = run; } }
        TOT[w * 64 + lane] = run;
        LBAR();
        float off = 0.f, cumtot = 0.f;
#pragma unroll
        for (int ww = 0; ww < 8; ++ww) { const float tv = TOT[ww * 64 + lane]; cumtot += tv; if (dir == 0 ? (ww < w) : (ww > w)) off += tv; }
        LAS float* CR = TOT + 512;
        if (dir == 0 ? (w == 3) : (w == 4)) CR[lane] = (dir == 0 ? cum[7] : cum[0]) + off;
        LBAR();
        const float cref = CR[lane];
#pragma unroll
        for (int jj = 0; jj < 8; ++jj) { const int i = w * 8 + jj, pp = dir ? 63 - i : i; const float lw = dir ? LB[jj] : LF[jj], cj = cum[jj] + off;
            const float al = -KN[jj] * expc_(cj - lw - cref), einv = expc_(cref - cj);
            AB[pp * LP + lane] = f2h(al); BBm[pp * LP + lane] = f2h(BE[jj] * einv); KBm[pp * LP + lane] = f2h(K2[jj] * einv);
            VT[lane * LP + pp] = f2h(V_[jj]);
            if (PC) S3[pp * LP + lane] = f2h(R_[jj] * expc_(cj - cref));
            else { const float ee = __expf(cumtot - cj); S3[lane * LP + pp] = f2h(BE[jj] * ee); S5[lane * LP + pp] = f2h(K2[jj] * ee); XT[lane * LP + pp] = f2h(al); } }
        if (PC) { const int row = tid >> 3, ch = tid & 7; const u32x4 hv = dir ? hv1 : hv0;
            const f32x4 h0 = unpack4h((u32x2){hv.x, hv.y}), h1 = unpack4h((u32x2){hv.z, hv.w}); const f32x4 e0 = *(const LAS f32x4*)(CR + ch * 8), e1 = *(const LAS f32x4*)(CR + ch * 8 + 4);
            f32x4 g0, g1;
#pragma unroll
            for (int j = 0; j < 4; ++j) { g0[j] = h0[j] * __expf(e0[j]); g1[j] = h1[j] * __expf(e1[j]); }
            const u32x2 p0 = pack4h(g0), p1 = pack4h(g1); *(LAS u32x4*)(S5 + row * LP + ch * 8) = (u32x4){p0.x, p0.y, p1.x, p1.y}; }
        LBAR();
        { bf16x8 fA[2], fR[2]; ldfrag2(AB, mtw * 16, r, q, fA); if (PC) ldfrag2(S3, mtw * 16, r, q, fR);
#pragma unroll
          for (int tt = 0; tt < 2; ++tt) { const int nt = ntw + tt, pp0 = mtw * 16 + q * 4, ss = nt * 16 + r;
            bf16x8 fB[2], fK[2]; ldfrag2(BBm, nt * 16, r, q, fB); ldfrag2(KBm, nt * 16, r, q, fK);
            f32x4 a = mm2h(fA, fB, (f32x4){0.f, 0.f, 0.f, 0.f});
#pragma unroll
            for (int j = 0; j < 4; ++j) { a[j] = (ss < pp0 + j) ? a[j] : 0.f; XP[(pp0 + j) * LP + ss] = f2h(a[j]); }
            *(LAS u32x2*)(XPT + ss * LP + pp0) = pack4h(a);
#pragma unroll
            for (int j = 0; j < 4; ++j) a[j] = (ss == pp0 + j) ? 1.f : a[j];
            *(LAS u32x2*)(YST + ss * LP + pp0) = pack4h(a);
            a = mm2h(fA, fK, (f32x4){0.f, 0.f, 0.f, 0.f});
#pragma unroll
            for (int j = 0; j < 4; ++j) AAK[(pp0 + j) * LP + ss] = f2h((ss < pp0 + j) ? a[j] : 0.f);
            if (PC) {
                a = mm2h(fR, fB, (f32x4){0.f, 0.f, 0.f, 0.f});
#pragma unroll
                for (int j = 0; j < 4; ++j) ARB[(pp0 + j) * LP + ss] = f2h((ss <= pp0 + j) ? a[j] : 0.f);
                a = mm2h(fR, fK, (f32x4){0.f, 0.f, 0.f, 0.f});
#pragma unroll
                for (int j = 0; j < 4; ++j) ARK[(pp0 + j) * LP + ss] = f2h((ss <= pp0 + j) ? a[j] : 0.f); } } }
        LBAR();
        { bf16x8 fP[2], fAk[2], fAb[2]; ldfrag2(XP, mtw * 16, r, q, fP); ldfrag2(AAK, mtw * 16, r, q, fAk); if (PC) ldfrag2(AB, mtw * 16, r, q, fAb);
#pragma unroll
          for (int tt = 0; tt < 2; ++tt) { const int nt = ntw + tt, pp0 = mtw * 16 + q * 4, ss = nt * 16 + r;
            bf16x8 fT[2], fV[2]; ldfrag2(XPT, nt * 16, r, q, fT); ldfrag2(VT, nt * 16, r, q, fV);
            const f32x4 c = mm2h(fP, fT, (f32x4){0.f, 0.f, 0.f, 0.f});
#pragma unroll
            for (int j = 0; j < 4; ++j) YP[(pp0 + j) * LP + ss] = f2h(c[j]);
            *(LAS u32x2*)(YPT + ss * LP + pp0) = pack4h(c);
            f32x4 x = mm2h(fAk, fV, (f32x4){0.f, 0.f, 0.f, 0.f});
            if (PC) { bf16x8 fH[2]; ldfrag2(S5, nt * 16, r, q, fH); x = mm2h(fAb, fH, x); *(LAS u32x2*)(XT + ss * LP + pp0) = pack4h(x); }
            else *(LAS u32x2*)(XT + (64 + ss) * LP + pp0) = pack4h(x); } }
        LBAR();
        for (int k = 1; k <= 5; ++k) {
            LAS bf16_t* sP = (k & 1) ? YP : XP; LAS bf16_t* sPT = (k & 1) ? YPT : XPT; LAS bf16_t* sST = (k & 1) ? YST : XST;
            LAS bf16_t* dP = (k & 1) ? XP : YP; LAS bf16_t* dPT = (k & 1) ? XPT : YPT; LAS bf16_t* dST = (k & 1) ? XST : YST;
            bf16x8 fP[2]; ldfrag2(sP, mtw * 16, r, q, fP);
#pragma unroll
            for (int tt = 0; tt < 2; ++tt) { const int nt = ntw + tt, pp0 = mtw * 16 + q * 4, ss = nt * 16 + r;
                bf16x8 fS[2]; ldfrag2(sST, nt * 16, r, q, fS);
                f32x4 a = unpack4h(*(const LAS u32x2*)(sST + ss * LP + pp0));
                a = mm2h(fP, fS, a);
                if (k < 5) {
                    *(LAS u32x2*)(dST + ss * LP + pp0) = pack4h(a);
                    bf16x8 fT[2]; ldfrag2(sPT, nt * 16, r, q, fT);
                    const f32x4 c = mm2h(fP, fT, (f32x4){0.f, 0.f, 0.f, 0.f});
#pragma unroll
                    for (int j = 0; j < 4; ++j) dP[(pp0 + j) * LP + ss] = f2h(c[j]);
                    *(LAS u32x2*)(dPT + ss * LP + pp0) = pack4h(c);
                } else {
#pragma unroll
                    for (int j = 0; j < 4; ++j) dP[(pp0 + j) * LP + ss] = f2h(a[j]); } }
            LBAR();
        }
        if (!PC) {
#pragma unroll
            for (int mt = 0; mt < 4; ++mt) { f32x4 a = {0.f, 0.f, 0.f, 0.f}; a = mma_tile_h<64>(XP + mt * 16 * LP, LP, XT + (w * 16) * LP, LP, a, r, q);
                *(LAS u32x2*)(UT + (w * 16 + r) * LP + mt * 16 + q * 4) = pack4h(a); }
            LBAR();
#pragma unroll
            for (int tt = 0; tt < 2; ++tt) { const int nt = ntw + tt;
                f32x4 a = {0.f, 0.f, 0.f, 0.f}; a = mma_tile_h<64>(S3 + mtw * 16 * LP, LP, UT + nt * 16 * LP, LP, a, r, q);
#pragma unroll
                for (int j = 0; j < 4; ++j) Mg[(mtw * 16 + q * 4 + j) * 64 + nt * 16 + r] = f2h(a[j] * __expf(CR[nt * 16 + r]));
                f32x4 n = {0.f, 0.f, 0.f, 0.f}; n = mma_tile_h<64>(S3 + mtw * 16 * LP, LP, UT + (64 + nt * 16) * LP, LP, n, r, q);
                n = mma_tile_h<64>(S5 + mtw * 16 * LP, LP, VT + nt * 16 * LP, LP, n, r, q);
                *(u32x2*)(Ng + (nt * 16 + r) * 64 + mtw * 16 + q * 4) = pack4h(n); }
            if (w == 0) Pg[lane] = __expf(cumtot);
            LBAR();
        } else {
            bf16x8 fTT[2]; ldfrag2(XP, mtw * 16, r, q, fTT);
#pragma unroll
            for (int tt = 0; tt < 2; ++tt) { const int nt = ntw + tt; bf16x8 fX[2]; ldfrag2(XT, nt * 16, r, q, fX); const f32x4 a = mm2h(fTT, fX, (f32x4){0.f, 0.f, 0.f, 0.f});
                *(LAS u32x2*)(UT + (nt * 16 + r) * LP + mtw * 16 + q * 4) = pack4h(a); }
            LBAR();
            f32x4 o[2];
            bf16x8 fRB[2], fARB[2], fARK[2]; ldfrag2(S3, mtw * 16, r, q, fRB); ldfrag2(ARB, mtw * 16, r, q, fARB); ldfrag2(ARK, mtw * 16, r, q, fARK);
#pragma unroll
            for (int tt = 0; tt < 2; ++tt) { const int nt = ntw + tt; bf16x8 fH[2], fU[2], fV[2]; ldfrag2(S5, nt * 16, r, q, fH); ldfrag2(UT, nt * 16, r, q, fU); ldfrag2(VT, nt * 16, r, q, fV);
                f32x4 a = mm2h(fRB, fH, (f32x4){0.f, 0.f, 0.f, 0.f}); a = mm2h(fARB, fU, a); a = mm2h(fARK, fV, a); o[tt] = a; }
            if (dir == 0) { Of[0] = o[0]; Of[1] = o[1]; LBAR(); }
            else {
                LBAR();
                LAS float* OS = (LAS float*)SLOT(6);
#pragma unroll
                for (int tt = 0; tt < 2; ++tt)
#pragma unroll
                    for (int j = 0; j < 4; ++j) OS[(mtw * 16 + q * 4 + j) * 64 + (ntw + tt) * 16 + r] = Of[tt][j];
                LBAR();
#pragma unroll
                for (int tt = 0; tt < 2; ++tt)
#pragma unroll
                    for (int j = 0; j < 4; ++j) OS[(63 - (mtw * 16 + q * 4 + j)) * 64 + (ntw + tt) * 16 + r] += o[tt][j];
                LBAR();
            }
        }
    }
    if (PC) {
        const LAS float* OS = (const LAS float*)SLOT(6); bf16_t* Y = (bf16_t*)(p.ws + (unsigned)opaque((int)WS_Y));
        const float lnw = p.in[opaque(28)][l * 384 + h * 64 + lane], lnb = p.in[opaque(29)][l * 384 + h * 64 + lane];
#pragma unroll
        for (int jj = 0; jj < 8; ++jj) { const int i = w * 8 + jj; const float o = OS[i * 64 + lane];
            const float mu = wave_sum(o) * (1.f / 64.f), dl = o - mu, var = wave_sum(dl * dl) * (1.f / 64.f);
            const float yv = dl * rsqrtf(var + 64e-5f) * lnw + lnb + BO[jj];
            Y[(size_t)(row0 + i) * D + 640 + h * 64 + lane] = f2bf(yv * GG[jj]); }
        LBAR();
    }
}

__device__ __forceinline__ void rw_passB(const Params& p, int unit, LAS unsigned char* lds) {
    const int tid = vopaque((int)threadIdx.x), lane = tid & 63, w = tid >> 6, r = lane & 15, q = lane >> 4;
    const int chain = unit >> 2, vs = unit & 3, dir = chain & 1, mt = w & 3; const bool act = w < 4;
    const bf16_t* Mg = (const bf16_t*)(p.ws + (unsigned)opaque((int)WS_RWM)) + (size_t)chain * NCH * 4096 + (mt * 16 + r) * 64 + q * 8;
    bf16_t* Ng = (bf16_t*)(p.ws + (unsigned)opaque((int)WS_RWN)) + (size_t)chain * NCH * 4096 + (vs * 16 + r) * 64 + mt * 16 + q * 4;
    const float* Pg = (const float*)(p.ws + (unsigned)opaque((int)WS_RWP)) + (size_t)chain * NCH * 64 + mt * 16 + q * 4;
    f32x4 hacc = {0.f, 0.f, 0.f, 0.f};
    bf16x8 Mq[6][2]; u32x2 Nq[6]; f32x4 Pq[6];
#define PB_LOAD(set, sidx) do { const int s_ = (sidx) < NCH ? (sidx) : NCH - 1; const int c_ = dir ? (s_ < 4 ? 3 - s_ : 135 - s_) : s_; \
        Mq[set][0] = *(const bf16x8*)(Mg + (size_t)c_ * 4096); Mq[set][1] = *(const bf16x8*)(Mg + (size_t)c_ * 4096 + 32); \
        Nq[set] = *(const u32x2*)(Ng + (size_t)c_ * 4096); Pq[set] = *(const f32x4*)(Pg + c_ * 64); } while (0)
    if (act) { PB_LOAD(0, 0); PB_LOAD(1, 1); PB_LOAD(2, 2); PB_LOAD(3, 3); PB_LOAD(4, 4); PB_LOAD(5, 5); }
    for (int s0 = 0; s0 < NCH; s0 += 6) {
#pragma unroll
        for (int u = 0; u < 6; ++u) { const int s = s0 + u, cs = dir ? (s < 4 ? 3 - s : 135 - s) : s;
            LAS bf16_t* HT = (LAS bf16_t*)(lds + (u & 1) * 4608);
            if (act) { const u32x2 hb = pack4h(hacc); const f32x4 hl = hacc - unpack4h(hb);
                *(u32x2*)(Ng + (size_t)cs * 4096) = hb;
                *(LAS u32x2*)(HT + r * LP + mt * 16 + q * 4) = hb; *(LAS u32x2*)(HT + 16 * LP + r * LP + mt * 16 + q * 4) = pack4h(hl); }
            asm volatile("s_waitcnt lgkmcnt(0)" ::: "memory"); __builtin_amdgcn_s_barrier(); asm volatile("" ::: "memory");
            if (act) {
                const bf16x8 B0 = *(const LAS bf16x8*)(HT + r * LP + q * 8), B1 = *(const LAS bf16x8*)(HT + r * LP + 32 + q * 8);
                const bf16x8 L0 = *(const LAS bf16x8*)(HT + 16 * LP + r * LP + q * 8), L1 = *(const LAS bf16x8*)(HT + 16 * LP + r * LP + 32 + q * 8);
                f32x4 a = Pq[u] * hacc + unpack4h(Nq[u]);
                a = __builtin_amdgcn_mfma_f32_16x16x32_f16(__builtin_bit_cast(half8_t, Mq[u][0]), __builtin_bit_cast(half8_t, L0), a, 0, 0, 0);
                a = __builtin_amdgcn_mfma_f32_16x16x32_f16(__builtin_bit_cast(half8_t, Mq[u][1]), __builtin_bit_cast(half8_t, L1), a, 0, 0, 0);
                a = __builtin_amdgcn_mfma_f32_16x16x32_f16(__builtin_bit_cast(half8_t, Mq[u][0]), __builtin_bit_cast(half8_t, B0), a, 0, 0, 0);
                a = __builtin_amdgcn_mfma_f32_16x16x32_f16(__builtin_bit_cast(half8_t, Mq[u][1]), __builtin_bit_cast(half8_t, B1), a, 0, 0, 0);
                hacc = a;
                PB_LOAD(u, s + 6);
            }
        }
    }
#undef PB_LOAD
    __syncthreads();
}

#define XB_TMO      128
#define XB_XCNT(j)  (256  + 64 * (j))
#define XB_XSUB(j)  (1280 + 64 * (j))
#define XB_XGEN(j)  (2304 + 64 * (j))
#define XB_TOP      3328
#define XB_TOPGEN   3392
#define XCD_BAR_WORDS 3456
#define XB_SPIN_CAP (1u << 18)

__device__ __forceinline__ unsigned xb_ld(unsigned* p)              { return __hip_atomic_load(p, __ATOMIC_RELAXED, __HIP_MEMORY_SCOPE_AGENT); }
__device__ __forceinline__ unsigned xb_add(unsigned* p, unsigned v) { return __hip_atomic_fetch_add(p, v, __ATOMIC_RELAXED, __HIP_MEMORY_SCOPE_AGENT); }
__device__ __forceinline__ unsigned xb_xcc_id() { return (unsigned)__builtin_amdgcn_s_getreg((3 << 11) | 20) & 0xFu; }
#define XB_SPIN(cond, bar) do { unsigned _sp = 0; while (cond) { __builtin_amdgcn_s_sleep(1); \
    if ((++_sp & 255u) == 0u) { if (xb_ld(&(bar)[XB_TMO])) break; if (_sp > XB_SPIN_CAP) { atomicAdd(&(bar)[XB_TMO], 1u); break; } } } } while (0)

struct XcdBarrier {
    unsigned* bar; unsigned x;
    volatile LAS unsigned* st;
};

__device__ __forceinline__ XcdBarrier xcd_barrier_post(unsigned* bar, volatile LAS unsigned* st) {
    XcdBarrier b; b.bar = bar; b.x = xb_xcc_id(); b.st = st;
    if (threadIdx.x == 0) (void)xb_add(&bar[XB_XCNT(b.x)], 1u);
    return b;
}
__device__ __forceinline__ void xcd_barrier_complete(unsigned* bar, unsigned x, unsigned& nloc, unsigned& nx) {
    const unsigned G = gridDim.x * gridDim.y * gridDim.z;
    unsigned sum, cnt, mine, sp = 0u;
    for (;;) {
        sum = 0u; cnt = 0u; mine = 0u;
#pragma unroll
        for (unsigned j = 0; j < 16; ++j) { const unsigned c = xb_ld(&bar[XB_XCNT(j)]); sum += c; cnt += (c > 0u) ? 1u : 0u; mine = (j == x) ? c : mine; }
        if (sum == G) break;
        __builtin_amdgcn_s_sleep(1);
        if ((++sp & 255u) == 0u) { if (xb_ld(&bar[XB_TMO])) break; if (sp > XB_SPIN_CAP) { atomicAdd(&bar[XB_TMO], 1u); break; } }
    }
    nloc = mine > 0u ? mine : 1u; nx = cnt > 0u ? cnt : 1u;
}

__device__ __forceinline__ void xcd_barrier(const XcdBarrier& b) {
    asm volatile("s_waitcnt vmcnt(0)" ::: "memory");
    __syncthreads();
    if (threadIdx.x == 0) {
        unsigned* bar = b.bar;
        __builtin_amdgcn_s_waitcnt(0);
        unsigned nloc = b.st[0], nx = b.st[1];
        if (nloc == 0u) { xcd_barrier_complete(bar, b.x, nloc, nx); b.st[0] = nloc; b.st[1] = nx; }
        const unsigned old = xb_add(&bar[XB_XSUB(b.x)], 1u);
        const unsigned gen = old / nloc;
        if (old + 1u == (gen + 1u) * nloc) {
            __builtin_amdgcn_fence(__ATOMIC_RELEASE, "agent");
            asm volatile("s_waitcnt vmcnt(0)" ::: "memory");
            const unsigned og = xb_add(&bar[XB_TOP], 1u);
            const unsigned tg = og / nx;
            if (og + 1u == (tg + 1u) * nx) xb_add(&bar[XB_TOPGEN], 1u);
            else XB_SPIN(xb_ld(&bar[XB_TOPGEN]) == tg, bar);
            __builtin_amdgcn_fence(__ATOMIC_ACQUIRE, "agent");
            xb_add(&bar[XB_XGEN(b.x)], 1u);
            asm volatile("s_waitcnt vmcnt(0)" ::: "memory");
        } else {
            XB_SPIN(xb_ld(&bar[XB_XGEN(b.x)]) == gen, bar);
            __builtin_amdgcn_fence(__ATOMIC_ACQUIRE, "agent");
            asm volatile("s_waitcnt vmcnt(0)" ::: "memory");
        }
    }
    __syncthreads();
}

__device__ __forceinline__ void ctx_gemm_items(const bf16_t* A, int lda, const bf16_t* Bt, int ldb, int nkc, float* part, LAS unsigned char* lds, int bid, int G) {
    const int tid = vopaque((int)threadIdx.x), lane = tid & 63, w = tid >> 6, r = lane & 15, q = lane >> 4;
    LAS bf16_t* As = (LAS bf16_t*)lds; LAS bf16_t* Bs = As + 64 * 264;
    const int nit = 128 * nkc;
    u32x4 ra[4], rbv[4];
#define CG_LOAD(itx) do { const int it_ = (itx) < nit ? (itx) : nit - 1; const int kc_ = it_ >> 7, rb_ = (it_ >> 4) & 7, cb_ = it_ & 15; \
        _Pragma("unroll") for (int u = 0; u < 4; ++u) { const int e = tid + u * 512, row = e >> 5, ch = e & 31; \
            ra[u] = *(const u32x4*)(A + (size_t)(rb_ * 64 + row) * lda + kc_ * 256 + ch * 8); rbv[u] = *(const u32x4*)(Bt + (size_t)(cb_ * 64 + row) * ldb + kc_ * 256 + ch * 8); } } while (0)
    if (bid < nit) CG_LOAD(bid);
    for (int it = bid; it < nit; it += G) { const int kc = it >> 7, rb = (it >> 4) & 7, cb = it & 15;
#pragma unroll
        for (int u = 0; u < 4; ++u) { const int e = tid + u * 512, row = e >> 5, ch = e & 31; *(LAS u32x4*)(As + row * 264 + ch * 8) = ra[u]; *(LAS u32x4*)(Bs + row * 264 + ch * 8) = rbv[u]; }
        LBAR();
        CG_LOAD(it + G);
        const int mt = w >> 1;
#pragma unroll
        for (int tt = 0; tt < 2; ++tt) { const int nt = (w & 1) * 2 + tt; f32x4 a = {0.f, 0.f, 0.f, 0.f}; a = mma_tile<256>(As + mt * 16 * 264, 264, Bs + nt * 16 * 264, 264, a, r, q);
#pragma unroll
            for (int j = 0; j < 4; ++j) part[((size_t)kc * MCTX + rb * 64 + mt * 16 + q * 4 + j) * D + cb * 64 + nt * 16 + r] = a[j]; }
        LBAR();
    }
#undef CG_LOAD
}

__global__ void __launch_bounds__(512, 2) fwd_kernel(Params p) {
    extern __shared__ __attribute__((aligned(16))) unsigned char lds_raw[];
    LAS unsigned char* lds = (LAS unsigned char*)lds_raw;
    cg::grid_group grid = cg::this_grid();
    const int bid = blockIdx.x, G = gridDim.x;
    volatile LAS unsigned* xst = (volatile LAS unsigned*)(lds + 163824);
    if (threadIdx.x == 0) { xst[0] = 0u; xst[1] = 0u; }
    __syncthreads();
    (void)xcd_barrier_post((unsigned*)(p.ws + (unsigned)opaque((int)WS_BAR)), xst);
#define XBAR() do { XcdBarrier xb_; xb_.bar = (unsigned*)(p.ws + (unsigned)opaque((int)WS_BAR)); xb_.x = xb_xcc_id(); xb_.st = (volatile LAS unsigned*)(lds + 163824); xcd_barrier(xb_); } while (0)

    mod_phase(p, lds, bid, G);
    __syncthreads();
    wconv_items(p, 0, 0, lds, bid, G);
    if (G == 0) grid.sync();
    XBAR();
    row_phase(p.in[opaque(0)], p.in[opaque(2)], nullptr, nullptr, nullptr, 0, nullptr, nullptr, p.in[opaque(6)], ((const float*)(p.ws + (unsigned)opaque((int)WS_MOD))), 0, 1024, ((bf16_t*)(p.ws + (unsigned)opaque((int)WS_Y))), MALL, bid, G);
    XBAR();
    for (int l = 0; l < 2; ++l) {
        const bool last = (l == 1); const int M = last ? MLAT : MALL;
        w2t_phase(p, l, bid, G);
        { pg8::Gemm g{((bf16_t*)(p.ws + (unsigned)opaque((int)WS_Y))), (const bf16_t*)((p.ws + (unsigned)opaque(0)) + WS_WIN), opaque(MALL), opaque(NU), opaque(D)}; pg8::StaticOrder S; S.init(g.M, g.N, G, bid); pg8::EpiBf16<0> E{((bf16_t*)(p.ws + (unsigned)opaque((int)WS_U))), NU, nullptr, 0, 0};
          pg8::gemm_phase<pg8::EpiBf16<0>, pg8::StaticOrder>(lds, g, S, E, nullptr); }
        XBAR();
        lr_pre_phase(p, l, bid, G);
        XBAR();
        for (int it = bid; it < 1584; it += G) rw_item<false>(p, l, it, last, lds);
        {
            unsigned* ctl = (unsigned*)(p.ws + (unsigned)opaque((int)WS_BAR)) + 3456 + l * 256 + 192;
            volatile LAS unsigned* tk = (volatile LAS unsigned*)(lds + 163832);
            for (;;) {
                if (threadIdx.x == 0) tk[0] = xb_add(ctl, 1u);
                __syncthreads();
                const unsigned t = tk[0];
                __syncthreads();
                if (t >= 2112u) break;
                la_item(p, l, (int)t, 1, last, lds);
            }
        }
        wconv_items(p, l, 1, lds, bid, G);
        XBAR();
        {
            unsigned* ctl = (unsigned*)(p.ws + (unsigned)opaque((int)WS_BAR)) + 3456 + l * 256;
            volatile LAS unsigned* tk = (volatile LAS unsigned*)(lds + 163832);
            if (bid < 96) {
                rw_passB(p, bid, lds);
                asm volatile("s_waitcnt vmcnt(0)" ::: "memory"); __syncthreads();
                if (threadIdx.x == 0) { __builtin_amdgcn_fence(__ATOMIC_RELEASE, "agent"); asm volatile("s_waitcnt vmcnt(0)" ::: "memory"); (void)xb_add(ctl + 64, 1u); }
            } else {
                la_scan(p, bid - 96, G - 96);
                asm volatile("s_waitcnt vmcnt(0)" ::: "memory"); __syncthreads();
                if (threadIdx.x == 0) {
                    __builtin_amdgcn_fence(__ATOMIC_RELEASE, "agent"); asm volatile("s_waitcnt vmcnt(0)" ::: "memory");
                    (void)xb_add(ctl + 128, 1u);
                    unsigned sp = 0; while (xb_ld(ctl + 128) < (unsigned)(G - 96)) { __builtin_amdgcn_s_sleep(1); if (++sp > (1u << 22)) break; }
                    __builtin_amdgcn_fence(__ATOMIC_ACQUIRE, "agent"); asm volatile("s_waitcnt vmcnt(0)" ::: "memory");
                }
                __syncthreads();
                for (;;) {
                    if (threadIdx.x == 0) { const bool done = xb_ld(ctl + 64) >= 96u; tk[0] = done ? 0x7fffffffu : xb_add(ctl, 1u); }
                    __syncthreads();
                    const unsigned t = tk[0];
                    __syncthreads();
                    if (t >= 2112u) break;
                    la_item(p, l, (int)t, 3, last, lds);
                }
            }
        }
        XBAR();
        for (int it = bid; it < 1584; it += G) rw_item<true>(p, l, it, last, lds);
        {
            unsigned* ctl = (unsigned*)(p.ws + (unsigned)opaque((int)WS_BAR)) + 3456 + l * 256;
            volatile LAS unsigned* tk = (volatile LAS unsigned*)(lds + 163832);
            for (;;) {
                if (threadIdx.x == 0) tk[0] = xb_add(ctl, 1u);
                __syncthreads();
                const unsigned t = tk[0];
                __syncthreads();
                if (t >= 2112u) break;
                la_item(p, l, (int)t, 3, last, lds);
            }
        }
        XBAR();
        { pg8::Gemm g{((bf16_t*)(p.ws + (unsigned)opaque((int)WS_Y))), (const bf16_t*)((p.ws + (unsigned)opaque(0)) + WS_WOUT), opaque(MLAT), opaque(D), opaque(D)}; pg8::StaticOrder S; S.init(g.M, g.N, G, bid); pg8::EpiBf16<0> E{((bf16_t*)(p.ws + (unsigned)opaque((int)WS_U))), D, nullptr, 0, 0};
          pg8::gemm_phase<pg8::EpiBf16<0>, pg8::StaticOrder>(lds, g, S, E, nullptr); }
        if (!last) ctx_gemm_items(((const bf16_t*)(p.ws + (unsigned)opaque((int)WS_Y))) + (size_t)MLAT * D, D, (const bf16_t*)((p.ws + (unsigned)opaque(0)) + WS_WOUT), D, 4, ((float*)(p.ws + (unsigned)opaque((int)WS_SRET))), lds, bid, G);
        XBAR();
        row_phase(l == 0 ? p.in[opaque(0)] : p.out, l == 0 ? p.in[opaque(2)] : ((float*)(p.ws + (unsigned)opaque((int)WS_CTX))), ((const bf16_t*)(p.ws + (unsigned)opaque((int)WS_U))), p.in[opaque(7)] + l * D, (((const float*)(p.ws + (unsigned)opaque((int)WS_MOD))) + l * 3 * 6144), 2048, p.out, ((float*)(p.ws + (unsigned)opaque((int)WS_CTX))), p.in[opaque(8)] + l * D, (((const float*)(p.ws + (unsigned)opaque((int)WS_MOD))) + l * 3 * 6144), 3072, 4096, ((bf16_t*)(p.ws + (unsigned)opaque((int)WS_Y))), M, bid, G, ((float*)(p.ws + (unsigned)opaque((int)WS_SRET))), last ? 0 : 4);
        wconv_items(p, l, 2, lds, bid, G);
        if (l == 0) wconv_items(p, 1, 0, lds, bid, G);
        XBAR();
        { pg8::Gemm g{((bf16_t*)(p.ws + (unsigned)opaque((int)WS_Y))), (const bf16_t*)((p.ws + (unsigned)opaque(0)) + WS_WGU), opaque(M), opaque(NGU), opaque(D)}; pg8::StaticOrder S; S.init(g.M, g.N, G, bid); pg8::EpiSwiGLU E{((bf16_t*)(p.ws + (unsigned)opaque((int)WS_U))), FF};
          pg8::gemm_phase<pg8::EpiSwiGLU, pg8::StaticOrder>(lds, g, S, E, nullptr); }
        XBAR();
        { pg8::Gemm g{((bf16_t*)(p.ws + (unsigned)opaque((int)WS_U))), (const bf16_t*)((p.ws + (unsigned)opaque(0)) + WS_WDN), opaque(MLAT), opaque(D), opaque(FF)}; pg8::StaticOrder S; S.init(g.M, g.N, G, bid); pg8::EpiBf16<0> E{((bf16_t*)(p.ws + (unsigned)opaque((int)WS_C2))), D, nullptr, 0, 0};
          pg8::gemm_phase<pg8::EpiBf16<0>, pg8::StaticOrder>(lds, g, S, E, nullptr); }
        if (!last) ctx_gemm_items(((const bf16_t*)(p.ws + (unsigned)opaque((int)WS_U))) + (size_t)MLAT * FF, FF, (const bf16_t*)((p.ws + (unsigned)opaque(0)) + WS_WDN), FF, 11, ((float*)(p.ws + (unsigned)opaque((int)WS_SRET))), lds, bid, G);
        XBAR();
        row_phase(p.out, ((float*)(p.ws + (unsigned)opaque((int)WS_CTX))), ((const bf16_t*)(p.ws + (unsigned)opaque((int)WS_C2))), p.in[opaque(9)] + l * D, (((const float*)(p.ws + (unsigned)opaque((int)WS_MOD))) + l * 3 * 6144), 5120, p.out, ((float*)(p.ws + (unsigned)opaque((int)WS_CTX))), last ? nullptr : p.in[opaque(6)] + (l + 1) * D, ((const float*)(p.ws + (unsigned)opaque((int)WS_MOD))) + (l + 1) * 3 * 6144, 0, 1024, last ? nullptr : ((bf16_t*)(p.ws + (unsigned)opaque((int)WS_Y))), M, bid, G, ((float*)(p.ws + (unsigned)opaque((int)WS_SRET))), last ? 0 : 11);
        if (!last) XBAR();
    }
}

extern "C" void kernel_launch(void* const* d_in, const int* in_sizes, int n_in, void* d_out, int out_size, void* d_ws, size_t ws_size, hipStream_t stream) {
    static int grid_blocks = 0;
    if (!grid_blocks) {
        int dev = 0, cus = 0, per_cu = 0;
        (void)hipGetDevice(&dev);
        (void)hipDeviceGetAttribute(&cus, hipDeviceAttributeMultiprocessorCount, dev);
        if (hipFuncSetAttribute((const void*)fwd_kernel, hipFuncAttributeMaxDynamicSharedMemorySize, LDS_BYTES) != hipSuccess) fprintf(stderr, "hipFuncSetAttribute failed\n");
        if (hipOccupancyMaxActiveBlocksPerMultiprocessor(&per_cu, (const void*)fwd_kernel, 512, LDS_BYTES) != hipSuccess || per_cu < 1) { fprintf(stderr, "occupancy query: %d\n", per_cu); per_cu = 1; }
        (void)hipGetLastError();
        grid_blocks = cus;
        if (ws_size < WS_END) fprintf(stderr, "workspace too small: %zu < %zu\n", ws_size, (size_t)WS_END);
    }
    Params p{};
    for (int i = 0; i < 34; ++i) p.in[i] = (const float*)d_in[i];
    p.out = (float*)d_out; p.ws = (unsigned char*)d_ws;
    (void)hipMemsetAsync((char*)d_ws + WS_BAR, 0, CTL_WORDS * 4, stream);
    void* args[] = {&p};
    hipError_t e = hipLaunchCooperativeKernel((const void*)fwd_kernel, dim3(grid_blocks), dim3(512), args, LDS_BYTES, stream);
    if (e != hipSuccess) fprintf(stderr, "cooperative launch failed: %s (grid %d)\n", hipGetErrorString(e), grid_blocks);
}
```

```cpp
#include <hip/hip_runtime.h>
#include <hip/hip_cooperative_groups.h>
#include <cstdio>
namespace cg = cooperative_groups;
namespace pg8 {
__device__ __forceinline__ int vopq(int v) { asm volatile("" : "+v"(v)); return v; }
#define PG8_LAS __attribute__((address_space(3)))
typedef unsigned short bf16_t;
typedef short bf16x8 __attribute__((ext_vector_type(8)));
typedef float f32x4 __attribute__((ext_vector_type(4)));
typedef unsigned u32x4 __attribute__((ext_vector_type(4)));
constexpr int BM = 256, BK = 64, HALF = 128, HTB = HALF * BK * 2  , STAGE_BYTES = 8 * HTB, NXCD = 8, WGM = 8;

__host__ __device__ __forceinline__ int lds_byte(int r, int c) { const int st = (r >> 4) * 2 + (c >> 5), rr = r & 15, cc = c & 31, ob = rr * 64 + cc * 2; return st * 1024 + (ob ^ (((ob >> 9) & 1) << 5)); }
__host__ __device__ __forceinline__ void stage_rc(int b, int& R, int& C) { const int st = b / 1024, sb = b % 1024, swz = sb ^ (((sb >> 9) & 1) << 5); R = (st >> 1) * 16 + swz / 64; C = (st & 1) * 32 + (swz % 64) / 2; }
__host__ __device__ __forceinline__ int perm32(int rho) { const int n = rho >> 4, i = rho & 15; return 8 * (i >> 2) + 4 * n + (i & 3); }

struct Unit { int pm, pn; };
struct Gemm { const bf16_t* A; const bf16_t* Bt; int M, N, K; };

struct StaticOrder {
    int nM, nN, nwg, G, c;
    __host__ __device__ void init(int M, int N, int G_, int c_) { nM = M / BM; nN = N / BM; nwg = nM * nN; G = G_; c = c_; }
    __host__ __device__ bool next(int i, Unit& u) const {
        const long L = (long)i * G + c; if (L >= nwg) return false;
        int wgid = (int)L; { const int q = nwg / NXCD, r = nwg % NXCD, xcd = wgid % NXCD, off = wgid / NXCD; wgid = (xcd < r ? xcd * (q + 1) : r * (q + 1) + (xcd - r) * q) + off; }
        const int nig = WGM * nN, gid = wgid / nig, fm = gid * WGM, gsz = (nM - fm) < WGM ? (nM - fm) : WGM;
        u.pm = fm + ((wgid % nig) % gsz); u.pn = (wgid % nig) / gsz; return true;
    }
    __device__ __forceinline__ void a_ready(const Unit&) const {}
    __device__ __forceinline__ void done(const Unit&) const {}
};
__device__ __forceinline__ unsigned cvt_pk_bf16(float lo, float hi) { unsigned r; asm volatile("v_cvt_pk_bf16_f32 %0, %1, %2" : "=v"(r) : "v"(lo), "v"(hi)); return r; }
typedef float f32x2 __attribute__((ext_vector_type(2)));
__device__ __forceinline__ f32x2 gelu_pk(f32x2 v) {
    const f32x2 av = __builtin_elementwise_abs(v), d = av * 0.2316418882f + 1.0f;
    f32x2 t; t.x = __builtin_amdgcn_rcpf(d.x); t.y = __builtin_amdgcn_rcpf(d.y);
    f32x2 q = t * 0.5307027145f + (-0.7265760135f); q = q * t + 0.7107068705f; q = q * t + (-0.142248368f); q = q * t + 0.127414796f; q = q * t;
    const f32x2 s = (v * v) * (-0.72134752044f);
    f32x2 e; e.x = __builtin_amdgcn_exp2f(s.x); e.y = __builtin_amdgcn_exp2f(s.y);
    const f32x2 m = v * (q * e), r = v - m;
    f32x2 o; o.x = v.x < 0.f ? m.x : r.x; o.y = v.y < 0.f ? m.y : r.y; return o;
}

struct EpiF32 {
    static constexpr bool PERM = false, AFTER_DRAIN = false;
    float* C; int ldc; const float* bias;
    __device__ __forceinline__ void operator()(const f32x4 (&acc)[2][2][4][2], const Unit& u, int wr, int wc, int fr, int fq) const {
        const int row0 = u.pm * BM + wr * 64 + fr, col0 = u.pn * BM + wc * 32 + 4 * fq;
        f32x4 bv[2][2];
#pragma unroll
        for (int bj = 0; bj < 2; ++bj)
#pragma unroll
            for (int n = 0; n < 2; ++n) bv[bj][n] = bias ? *(const f32x4*)(bias + col0 + bj * HALF + n * 16) : (f32x4){0.f, 0.f, 0.f, 0.f};
#pragma unroll
        for (int ai = 0; ai < 2; ++ai)
#pragma unroll
            for (int m = 0; m < 4; ++m) { float* rowp = C + (size_t)(row0 + ai * HALF + m * 16) * ldc + col0;
#pragma unroll
                for (int bj = 0; bj < 2; ++bj)
#pragma unroll
                    for (int n = 0; n < 2; ++n) *(f32x4*)(rowp + bj * HALF + n * 16) = acc[ai][bj][m][n] + bv[bj][n]; }
    }
};
template <int ACT  > struct EpiBf16 {
    static constexpr bool PERM = true, AFTER_DRAIN = false;
    bf16_t* O; int ldc; const float* bias; int split_cols; size_t split_stride;
    __device__ __forceinline__ void operator()(const f32x4 (&acc)[2][2][4][2], const Unit& u, int wr, int wc, int fr, int fq) const {
        const int row0 = u.pm * BM + wr * 64 + fr; int colt = u.pn * BM; bf16_t* base = O;
        if (split_cols) { const int t = colt / split_cols; base += (size_t)t * split_stride; colt -= t * split_cols; }
        const int col0 = colt + wc * 32 + 8 * fq, bcol0 = u.pn * BM + wc * 32 + 8 * fq;
        f32x4 bv[2][2];
#pragma unroll
        for (int bj = 0; bj < 2; ++bj)
#pragma unroll
            for (int n = 0; n < 2; ++n) bv[bj][n] = bias ? *(const f32x4*)(bias + bcol0 + bj * HALF + 4 * n) : (f32x4){0.f, 0.f, 0.f, 0.f};
#pragma unroll
        for (int ai = 0; ai < 2; ++ai)
#pragma unroll
            for (int m = 0; m < 4; ++m) { bf16_t* rowp = base + (size_t)(row0 + ai * HALF + m * 16) * ldc + col0;
#pragma unroll
                for (int bj = 0; bj < 2; ++bj) { f32x4 v0 = acc[ai][bj][m][0] + bv[bj][0], v1 = acc[ai][bj][m][1] + bv[bj][1];
                    if (ACT == 1) { f32x2 a = gelu_pk((f32x2){v0[0], v0[1]}), b = gelu_pk((f32x2){v0[2], v0[3]}), c = gelu_pk((f32x2){v1[0], v1[1]}), d = gelu_pk((f32x2){v1[2], v1[3]});
                        v0 = (f32x4){a.x, a.y, b.x, b.y}; v1 = (f32x4){c.x, c.y, d.x, d.y}; }
                    if (ACT == 2) {
#pragma unroll
                        for (int j = 0; j < 4; ++j) { v0[j] = 0.5f * v0[j] * (1.0f + erff(v0[j] * 0.70710678f)); v1[j] = 0.5f * v1[j] * (1.0f + erff(v1[j] * 0.70710678f)); } }
                    u32x4 w; w.x = cvt_pk_bf16(v0[0], v0[1]); w.y = cvt_pk_bf16(v0[2], v0[3]); w.z = cvt_pk_bf16(v1[0], v1[1]); w.w = cvt_pk_bf16(v1[2], v1[3]);
                    *(u32x4*)(rowp + bj * HALF) = w; } }
    }
};
template <class Epi, class Sched, bool STAMP = false>
__device__ __forceinline__ void gemm_phase(PG8_LAS unsigned char* lds, const Gemm g, const Sched& S, const Epi& E, unsigned long long* stamps) {
    const int tid = vopq((int)threadIdx.x), wid = __builtin_amdgcn_readfirstlane(tid >> 6), lane = tid & 63, wr = wid >> 2, wc = wid & 3, fr = lane & 15, fq = lane >> 4;
    const int K = g.K, nt = K / BK;
    int ts_lo = 0, ts_hi = 0, nts = 0; const unsigned long long rt_entry = STAMP ? (unsigned long long)wall_clock64() : 0ull;
#define PG8_STAMP() do { if (STAMP && wid == 0 && nts < 64) { const unsigned long long _c = (unsigned long long)clock64(); \
        ts_lo = (lane == nts) ? (int)(unsigned)_c : ts_lo; ts_hi = (lane == nts) ? (int)(unsigned)(_c >> 32) : ts_hi; ++nts; } } while (0)
    PG8_STAMP();
    unsigned voffA[2], voffB[2];
#pragma unroll
    for (int i = 0; i < 2; ++i) { int R, C; stage_rc(tid * 16 + i * 8192, R, C); const int Rb = Epi::PERM ? ((R & ~31) + perm32(R & 31)) : R;
        voffA[i] = (unsigned)(R * K + C) * 2u; voffB[i] = (unsigned)(Rb * K + C) * 2u; }
    const size_t kstep = (size_t)(BK * 2);
    const size_t hstep = (size_t)HALF * K * 2;
    const size_t tstep = 2 * hstep;
    const unsigned ldsw = (unsigned)wid * 1024u;
    const int aoff = lds_byte(wr * 64 + fr, fq * 8), boff = lds_byte(wc * 32 + fr, fq * 8);
#define PG8_SA(b, h) (((b) * 2 + (h)) * HTB)
#define PG8_SB(b, h) ((4 + (b) * 2 + (h)) * HTB)
#define PG8_STAGE(bufoff, gbase, voff) do { _Pragma("unroll") for (int _i = 0; _i < 2; ++_i) \
        __builtin_amdgcn_global_load_lds((const unsigned*)((const char*)(gbase) + (voff)[_i]), (PG8_LAS unsigned*)(lds + (bufoff) + ldsw + _i * 8192), 16, 0, 0); } while (0)
#define PG8_LDA(dst, b, h) do { _Pragma("unroll") for (int m = 0; m < 4; ++m) _Pragma("unroll") for (int k = 0; k < 2; ++k) dst[m][k] = *(const PG8_LAS bf16x8*)(lds + PG8_SA(b, h) + aoff + m * 2048 + k * 1024); } while (0)
#define PG8_LDB(dst, b, h) do { _Pragma("unroll") for (int n = 0; n < 2; ++n) _Pragma("unroll") for (int k = 0; k < 2; ++k) dst[n][k] = *(const PG8_LAS bf16x8*)(lds + PG8_SB(b, h) + boff + n * 2048 + k * 1024); } while (0)
#define PG8_MMA(ai, bj, At, Bt) do { __builtin_amdgcn_s_setprio(1); _Pragma("unroll") for (int m = 0; m < 4; ++m) _Pragma("unroll") for (int n = 0; n < 2; ++n) _Pragma("unroll") for (int k = 0; k < 2; ++k) \
        acc[ai][bj][m][n] = __builtin_amdgcn_mfma_f32_16x16x32_bf16(Bt[n][k], At[m][k], acc[ai][bj][m][n], 0, 0, 0); __builtin_amdgcn_s_setprio(0); } while (0)
#define PG8_WAIT_V(n) asm volatile("s_waitcnt vmcnt(" #n ")" ::: "memory")
#define PG8_WAIT_L(n) asm volatile("s_waitcnt lgkmcnt(" #n ")" ::: "memory")
#define PG8_BAR __builtin_amdgcn_s_barrier()
#define PG8_SCHED __builtin_amdgcn_sched_barrier(0)
    Unit cur, nxt; int ui = 0;
    if (!S.next(0, cur)) return;
    f32x4 acc[2][2][4][2];
#pragma unroll
    for (int a = 0; a < 2; ++a)
#pragma unroll
        for (int b = 0; b < 2; ++b)
#pragma unroll
            for (int m = 0; m < 4; ++m)
#pragma unroll
                for (int n = 0; n < 2; ++n) acc[a][b][m][n] = (f32x4){0.f, 0.f, 0.f, 0.f};
    bf16x8 At[4][2], B0[2][2], B1[2][2];
    const char* cA = (const char*)g.A + (size_t)cur.pm * tstep; const char* cB = (const char*)g.Bt + (size_t)cur.pn * tstep;
    S.a_ready(cur);
    PG8_STAGE(PG8_SB(0, 0), cB, voffB); PG8_STAGE(PG8_SA(0, 0), cA, voffA); PG8_STAGE(PG8_SB(0, 1), cB + hstep, voffB); PG8_STAGE(PG8_SA(0, 1), cA + hstep, voffA);
    if (wr == 1) PG8_BAR;
    PG8_WAIT_V(4); PG8_BAR;
    PG8_STAGE(PG8_SB(1, 0), cB + kstep, voffB); PG8_STAGE(PG8_SA(1, 0), cA + kstep, voffA); PG8_STAGE(PG8_SB(1, 1), cB + hstep + kstep, voffB);
    PG8_WAIT_V(6); PG8_BAR;
    PG8_STAMP();
    for (;;) {
        const bool has_next = S.next(ui + 1, nxt);
        const char* nA = has_next ? (const char*)g.A + (size_t)nxt.pm * tstep : cA; const char* nB = has_next ? (const char*)g.Bt + (size_t)nxt.pn * tstep : cB;
        for (int t = 0; t < nt; t += 2) {
            const bool last = (t == nt - 2);
            const char* a1 = cA + (size_t)(t + 1) * kstep;
            const char* a2 = last ? nA : cA + (size_t)(t + 2) * kstep; const char* b2 = last ? nB : cB + (size_t)(t + 2) * kstep;
            const char* a3 = a2 + kstep; const char* b3 = b2 + kstep;
            if (last && has_next) S.a_ready(nxt);
            PG8_LDB(B0, 0, 0); PG8_SCHED; PG8_LDA(At, 0, 0); PG8_STAGE(PG8_SA(1, 1), a1 + hstep, voffA);
            PG8_WAIT_L(8); PG8_BAR; PG8_WAIT_L(0); PG8_MMA(0, 0, At, B0); PG8_BAR; PG8_SCHED;
            PG8_LDB(B1, 0, 1); PG8_STAGE(PG8_SB(0, 0), b2, voffB);
            PG8_BAR; PG8_WAIT_L(0); PG8_MMA(0, 1, At, B1); PG8_BAR;
            PG8_LDA(At, 0, 1); PG8_STAGE(PG8_SA(0, 0), a2, voffA);
            PG8_BAR; PG8_WAIT_L(0); PG8_MMA(1, 0, At, B0); PG8_BAR; PG8_SCHED;
            PG8_STAGE(PG8_SB(0, 1), b2 + hstep, voffB);
            PG8_WAIT_V(6); PG8_BAR; PG8_MMA(1, 1, At, B1); PG8_BAR;
            PG8_LDB(B0, 1, 0); PG8_SCHED; PG8_LDA(At, 1, 0); PG8_STAGE(PG8_SA(0, 1), a2 + hstep, voffA);
            PG8_WAIT_L(8); PG8_BAR; PG8_WAIT_L(0); PG8_MMA(0, 0, At, B0); PG8_BAR; PG8_SCHED;
            PG8_LDB(B1, 1, 1); PG8_STAGE(PG8_SB(1, 0), b3, voffB);
            PG8_BAR; PG8_WAIT_L(0); PG8_MMA(0, 1, At, B1); PG8_BAR;
            PG8_LDA(At, 1, 1); PG8_STAGE(PG8_SA(1, 0), a3, voffA);
            PG8_BAR; PG8_WAIT_L(0); PG8_MMA(1, 0, At, B0); PG8_BAR; PG8_SCHED;
            PG8_STAGE(PG8_SB(1, 1), b3 + hstep, voffB);
            PG8_WAIT_V(6); PG8_BAR; PG8_MMA(1, 1, At, B1); PG8_BAR;
        }
        PG8_STAMP();
        if constexpr (!Epi::AFTER_DRAIN) { E(acc, cur, wr, wc, fr, fq); S.done(cur); }
        PG8_STAMP();
        if (!has_next) break;
#pragma unroll
        for (int a = 0; a < 2; ++a)
#pragma unroll
            for (int b = 0; b < 2; ++b)
#pragma unroll
                for (int m = 0; m < 4; ++m)
#pragma unroll
                    for (int n = 0; n < 2; ++n) acc[a][b][m][n] = (f32x4){0.f, 0.f, 0.f, 0.f};
        cur = nxt; cA = nA; cB = nB; ++ui;
    }
    PG8_WAIT_V(0);
    if (wr == 0) PG8_BAR;
    PG8_BAR;
    if constexpr (Epi::AFTER_DRAIN) { E.fused(acc, cur, wr, wc, fr, fq, lds, wid, lane); S.done(cur); }
    PG8_STAMP();
    if (STAMP && wid == 0) { stamps[lane] = lane < nts ? (((unsigned long long)(unsigned)ts_hi << 32) | (unsigned)ts_lo) : 0ull;
        if (lane == 62) stamps[62] = rt_entry; if (lane == 63) stamps[63] = (unsigned long long)wall_clock64(); }
#undef PG8_STAMP
#undef PG8_SA
#undef PG8_SB
#undef PG8_STAGE
#undef PG8_LDA
#undef PG8_LDB
#undef PG8_MMA
#undef PG8_WAIT_V
#undef PG8_WAIT_L
#undef PG8_BAR
#undef PG8_SCHED
}
}
namespace pg8 {
struct EpiSwiGLU {
    static constexpr bool PERM = true, AFTER_DRAIN = false;
    bf16_t* H; int ldh;
    __device__ __forceinline__ void operator()(const f32x4 (&acc)[2][2][4][2], const Unit& u, int wr, int wc, int fr, int fq) const {
        const int row0 = u.pm * BM + wr * 64 + fr, col0 = u.pn * HALF + wc * 32 + 8 * fq;
#pragma unroll
        for (int ai = 0; ai < 2; ++ai)
#pragma unroll
            for (int m = 0; m < 4; ++m) { bf16_t* rowp = H + (size_t)(row0 + ai * HALF + m * 16) * ldh + col0;
                float hv[8];
#pragma unroll
                for (int n = 0; n < 2; ++n)
#pragma unroll
                    for (int j = 0; j < 4; ++j) { const float g = acc[ai][0][m][n][j], up = acc[ai][1][m][n][j]; hv[n * 4 + j] = g * up * __builtin_amdgcn_rcpf(1.0f + __expf(-g)); }
                u32x4 w; w.x = cvt_pk_bf16(hv[0], hv[1]); w.y = cvt_pk_bf16(hv[2], hv[3]); w.z = cvt_pk_bf16(hv[4], hv[5]); w.w = cvt_pk_bf16(hv[6], hv[7]);
                *(u32x4*)rowp = w; }
    }
};
}

#define LAS __attribute__((address_space(3)))
typedef unsigned short bf16_t;
typedef short bf16x8 __attribute__((ext_vector_type(8)));
typedef float f32x4 __attribute__((ext_vector_type(4)));
typedef unsigned u32x4 __attribute__((ext_vector_type(4)));
typedef unsigned u32x2 __attribute__((ext_vector_type(2)));

constexpr int D = 1024, MLAT = 16384, MCTX = 512, MALL = 16896, SEQ = 8192, CTXL = 256, NCH = 132;
constexpr int INW = 3680, NU = 3840, FF = 2816, NGU = 5632;
constexpr size_t WS_MOD = 0;
constexpr size_t WS_CTX = 147456;
constexpr size_t WS_WA = WS_CTX + (size_t)MCTX * D * 4;
constexpr size_t WA_BYTES = (size_t)3168 * 8192;
constexpr size_t WS_WGU = WS_WA;
constexpr size_t WS_WDN = WS_WGU + (size_t)NGU * D * 2;
constexpr size_t WS_WIN = WS_WDN + (size_t)D * FF * 2;
constexpr size_t WS_RWN = WS_WA;
static_assert(WS_WIN + (size_t)NU * D * 2 <= WS_WA + WA_BYTES, "region A");
constexpr size_t WS_WOUT = WS_WA + WA_BYTES;
constexpr size_t WS_U = WS_WOUT + (size_t)D * D * 2;
constexpr size_t U_BYTES = (size_t)MALL * NU * 2;
constexpr size_t H_BYTES = (size_t)MALL * FF * 2;
constexpr size_t C_BYTES = (size_t)MALL * D * 4;
constexpr size_t WS_C2 = WS_U + H_BYTES;
constexpr size_t WS_RWM = WS_U + U_BYTES;
constexpr size_t WS_RWP = WS_RWM + (size_t)3168 * 8192;
constexpr size_t WS_W2T = WS_RWP + (size_t)3168 * 256;
constexpr size_t WS_ACT = WS_W2T + (size_t)6 * 20480 * 2;
constexpr size_t WS_Y = WS_C2 + C_BYTES;
constexpr size_t WS_SRET = WS_Y + (size_t)MALL * D * 2;
constexpr size_t WS_SGLA = WS_SRET + (size_t)16 * NCH * 4096 * 2;
constexpr size_t WS_DEC = WS_SGLA + (size_t)16 * NCH * 4608 * 2;
constexpr size_t WS_END = WS_DEC + (size_t)32 * NCH * 64 * 4;
static_assert(WS_ACT + (size_t)MALL * 192 * 2 <= WS_Y, "tail overlaps y");
constexpr size_t WS_BAR = WS_END;
constexpr int CTL_WORDS = 3456 + 512;
static_assert(WS_BAR + CTL_WORDS * 4 <= (size_t)268435456, "workspace too large");
constexpr int LDS_BYTES = 163840;
#ifndef PHM
#define PHM 0xFFFF
#endif

struct Params { const float* in[34]; float* out; unsigned char* ws; };

__device__ __forceinline__ int opaque(int v) { asm volatile("" : "+s"(v)); return v; }
__device__ __forceinline__ int vopaque(int v) { asm volatile("" : "+v"(v)); return v; }
typedef __bf16 bf16v2_t __attribute__((ext_vector_type(2)));
typedef float f32x2_t __attribute__((ext_vector_type(2)));
__device__ __forceinline__ unsigned pk2(float lo, float hi) { const f32x2_t v = {lo, hi}; const bf16v2_t b = __builtin_convertvector(v, bf16v2_t); return __builtin_bit_cast(unsigned, b); }
__device__ __forceinline__ bf16_t f2bf(float f) { return (bf16_t)(pk2(f, 0.f) & 0xffffu); }
__device__ __forceinline__ float bf2f(bf16_t b) { return __uint_as_float(((unsigned)b) << 16); }
template <int CTRL, int RMASK> __device__ __forceinline__ float dpp_(float v) { return __builtin_bit_cast(float, __builtin_amdgcn_update_dpp(0, __builtin_bit_cast(int, v), CTRL, RMASK, 0xf, false)); }
__device__ __forceinline__ float row16_sum(float v) {
    v += dpp_<0xb1, 0xf>(v); v += dpp_<0x4e, 0xf>(v); v += dpp_<0x124, 0xf>(v); v += dpp_<0x128, 0xf>(v); return v; }
__device__ __forceinline__ float wave_sum(float v) {
    v = row16_sum(v); v += dpp_<0x142, 0xa>(v); v += dpp_<0x143, 0xc>(v);
    return __builtin_bit_cast(float, __builtin_amdgcn_readlane(__builtin_bit_cast(int, v), 63)); }
__device__ __forceinline__ float sigmoidf_(float x) { return 1.f / (1.f + __expf(-x)); }
__device__ __forceinline__ float siluf_(float x) { return x / (1.f + __expf(-x)); }
__device__ __forceinline__ int chunk_row0(int b, int cs) { return cs < 4 ? MLAT + b * CTXL + cs * 64 : b * SEQ + (cs - 4) * 64; }

template <int K> __device__ __forceinline__ f32x4 mma_tile(const LAS bf16_t* A, int lda, const LAS bf16_t* Bt, int ldb, f32x4 acc, int r, int q) {
#pragma unroll
    for (int k0 = 0; k0 < K; k0 += 32) {
        const bf16x8 a = *(const LAS bf16x8*)(A + r * lda + k0 + q * 8);
        const bf16x8 b = *(const LAS bf16x8*)(Bt + r * ldb + k0 + q * 8);
        acc = __builtin_amdgcn_mfma_f32_16x16x32_bf16(a, b, acc, 0, 0, 0);
    }
    return acc;
}

__device__ __forceinline__ void mod_phase(const Params& p, LAS unsigned char* lds, int bid, int nb) {
    LAS float* sc = (LAS float*)lds;
    LAS float* red = sc + 3072;
    const int tid = vopaque((int)threadIdx.x);
    for (int i = tid; i < 3072; i += 512) { const int s = i >> 10, k = i & 1023; const float v = s < 2 ? p.in[opaque(1)][s * 1024 + k] : p.in[opaque(3)][k]; sc[i] = siluf_(v); }
    __syncthreads();
    const int col = tid & 63, kg = tid >> 6;
    float* modo = (float*)(p.ws + (unsigned)opaque((int)WS_MOD));
    for (int it = bid; it < 192; it += nb) {
        const int l = it / 96, c0 = (it % 96) * 64;
        const float* W = p.in[opaque(4)] + (size_t)l * D * 6144 + c0 + col;
        float a0 = 0.f, a1 = 0.f, a2 = 0.f;
#pragma unroll 32
        for (int k = kg * 128; k < kg * 128 + 128; ++k) { const float w = W[(size_t)k * 6144]; a0 += sc[k] * w; a1 += sc[1024 + k] * w; a2 += sc[2048 + k] * w; }
        red[(kg * 3 + 0) * 64 + col] = a0; red[(kg * 3 + 1) * 64 + col] = a1; red[(kg * 3 + 2) * 64 + col] = a2;
        __syncthreads();
        if (tid < 192) { const int s = tid >> 6; float t = 0.f;
#pragma unroll
            for (int g = 0; g < 8; ++g) t += red[(g * 3 + s) * 64 + col];
            modo[(l * 3 + s) * 6144 + c0 + col] = t + p.in[opaque(5)][l * 6144 + c0 + col]; }
        __syncthreads();
    }
}

__device__ __forceinline__ void wt_item(const float* src, int ldw, bool zero, bf16_t* dst, int K, LAS float* scr, int lane) {
    float tv[32];
#pragma unroll
    for (int i = 0; i < 32; ++i) { const int kk = 2 * i + (lane >> 5); tv[i] = zero ? 0.f : src[(size_t)kk * ldw + (lane & 31)]; }
#pragma unroll
    for (int i = 0; i < 32; ++i) { const int kk = 2 * i + (lane >> 5); scr[kk * 33 + (lane & 31)] = tv[i]; }
    asm volatile("s_waitcnt lgkmcnt(0)" ::: "memory");
    const int c = lane & 7;
#pragma unroll
    for (int j = 0; j < 4; ++j) { const int n = (lane >> 3) + 8 * j; const LAS float* s = scr + (8 * c) * 33 + n;
        u32x4 o; o.x = pk2(s[0], s[33]); o.y = pk2(s[66], s[99]); o.z = pk2(s[132], s[165]); o.w = pk2(s[198], s[231]);
        *(u32x4*)(dst + (size_t)n * K + 8 * c) = o; }
    asm volatile("s_waitcnt lgkmcnt(0)" ::: "memory");
}
__device__ __forceinline__ void wconv_items(const Params& p, int l, int set, LAS unsigned char* lds, int bid, int G) {
    unsigned char* ws = p.ws; const int tid = vopaque((int)threadIdx.x), lane = tid & 63, wv = tid >> 6, gw = bid * 8 + wv, ngw = G * 8; LAS float* scr = (LAS float*)(lds + wv * 8448);
    if (set == 0) {
        const float* W = p.in[opaque(10)] + (size_t)l * D * INW;
        for (int it = gw; it < 120 * 16; it += ngw) { const int kb = it / 120, nb = it % 120;
            wt_item(W + (size_t)(kb * 64) * INW + nb * 32, INW, nb * 32 >= INW, (bf16_t*)(ws + WS_WIN) + (size_t)(nb * 32) * D + kb * 64, D, scr, lane); }
    } else {
        for (int it = gw + (set == 2 ? 512 : 0); it < (set == 2 ? 512 + 2816 + 1408 : 512); it += ngw) {
            int r = it;
            if (r < 512) { const int kb = r / 32, nb = r % 32;
                wt_item(p.in[opaque(30)] + (size_t)l * D * D + (size_t)(kb * 64) * D + nb * 32, D, false, (bf16_t*)(ws + WS_WOUT) + (size_t)(nb * 32) * D + kb * 64, D, scr, lane); continue; }
            r -= 512;
            if (r < 2816) { const int kb = r / 176, nb = r % 176; const int n0 = nb * 32, tile = n0 >> 8, within = n0 & 255, hid = tile * 128 + (within & 127);
                const float* W = (within < 128 ? p.in[opaque(31)] : p.in[opaque(32)]) + (size_t)l * D * FF;
                wt_item(W + (size_t)(kb * 64) * FF + hid, FF, false, (bf16_t*)(ws + WS_WGU) + (size_t)n0 * D + kb * 64, D, scr, lane); continue; }
            r -= 2816;
            { const int kb = r / 32, nb = r % 32;
                wt_item(p.in[opaque(33)] + (size_t)l * FF * D + (size_t)(kb * 64) * D + nb * 32, D, false, (bf16_t*)(ws + WS_WDN) + (size_t)(nb * 32) * FF + kb * 64, FF, scr, lane); }
        }
    }
}

__device__ __forceinline__ void row_phase(const float* res_lat, const float* res_ctx, const bf16_t* Cm, const float* gpost, const float* modg, int gate_off,
                                          float* dst_lat, float* dst_ctx, const float* gpre, const float* modn, int sh_off, int sc_off, bf16_t* xn, int M, int bid, int G, const float* part = nullptr, int npart = 0) {
    const int tid = vopaque((int)threadIdx.x), lane = tid & 63, gw = bid * 8 + (tid >> 6), ngw = G * 8;
    f32x4 nv[4], nc[4];
#define RP_LOAD(mm) do { const int m_ = (mm); const float* rr_ = m_ >= MLAT ? res_ctx + (size_t)(m_ - MLAT) * D : res_lat + (size_t)m_ * D; \
        _Pragma("unroll") for (int j = 0; j < 4; ++j) { nv[j] = *(const f32x4*)(rr_ + j * 256 + lane * 4); \
            if (Cm) { if (npart > 0 && m_ >= MLAT) { f32x4 t_ = {0.f, 0.f, 0.f, 0.f}; for (int k_ = 0; k_ < npart; ++k_) t_ = t_ + *(const f32x4*)(part + ((size_t)k_ * MCTX + (m_ - MLAT)) * D + j * 256 + lane * 4); nc[j] = t_; } \
                      else { const u32x2 c_ = *(const u32x2*)(Cm + (size_t)m_ * D + j * 256 + lane * 4); nc[j] = (f32x4){__uint_as_float(c_.x << 16), __uint_as_float(c_.x & 0xffff0000u), __uint_as_float(c_.y << 16), __uint_as_float(c_.y & 0xffff0000u)}; } } } } while (0)
    if (gw < M) RP_LOAD(gw);
    for (int m = gw; m < M; m += ngw) {
        const bool isctx = m >= MLAT; const int ms = isctx ? 2 : (m >> 13);
        f32x4 v[4], c[4];
#pragma unroll
        for (int j = 0; j < 4; ++j) { v[j] = nv[j]; c[j] = nc[j]; }
        if (m + ngw < M) RP_LOAD(m + ngw);
        if (Cm) {
            f32x4 gp[4], gt[4]; float ss = 0.f;
#pragma unroll
            for (int j = 0; j < 4; ++j) { const int col = j * 256 + lane * 4; gp[j] = *(const f32x4*)(gpost + col); gt[j] = *(const f32x4*)(modg + ms * 6144 + gate_off + col);
                ss += c[j][0] * c[j][0] + c[j][1] * c[j][1] + c[j][2] * c[j][2] + c[j][3] * c[j][3]; }
            ss = wave_sum(ss); const float rstd = rsqrtf(ss * (1.f / 1024.f) + 1e-6f);
#pragma unroll
            for (int j = 0; j < 4; ++j) v[j] = v[j] + gt[j] * (c[j] * rstd * gp[j]);
        }
        if (dst_lat) { float* drow = isctx ? dst_ctx + (size_t)(m - MLAT) * D : dst_lat + (size_t)m * D;
#pragma unroll
            for (int j = 0; j < 4; ++j) *(f32x4*)(drow + j * 256 + lane * 4) = v[j]; }
        if (xn) {
            f32x4 gp[4], sh[4], sc[4]; float ss = 0.f;
#pragma unroll
            for (int j = 0; j < 4; ++j) { const int col = j * 256 + lane * 4; gp[j] = *(const f32x4*)(gpre + col); sh[j] = *(const f32x4*)(modn + ms * 6144 + sh_off + col); sc[j] = *(const f32x4*)(modn + ms * 6144 + sc_off + col);
                ss += v[j][0] * v[j][0] + v[j][1] * v[j][1] + v[j][2] * v[j][2] + v[j][3] * v[j][3]; }
            ss = wave_sum(ss); const float rstd = rsqrtf(ss * (1.f / 1024.f) + 1e-6f);
#pragma unroll
            for (int j = 0; j < 4; ++j) { const int col = j * 256 + lane * 4; const f32x4 y = (v[j] * rstd * gp[j]) * (sc[j] + 1.f) + sh[j];
                u32x2 o; o.x = pk2(y[0], y[1]); o.y = pk2(y[2], y[3]); *(u32x2*)(xn + (size_t)m * D + col) = o; }
        }
    }
#undef RP_LOAD
}

constexpr int LP = 72;
#define LBAR() do { asm volatile("s_waitcnt lgkmcnt(0)" ::: "memory"); __builtin_amdgcn_s_barrier(); asm volatile("" ::: "memory"); } while (0)
__device__ __forceinline__ float logsig_(float z) { return fminf(z, 0.f) - __logf(1.f + __expf(-fabsf(z))); }
__device__ __forceinline__ void la_item(const Params& p, int l, int idx, int pass, bool last, LAS unsigned char* lds) {
    const int tid = vopaque((int)threadIdx.x), lane = tid & 63, w = tid >> 6, r = lane & 15, q = lane >> 4;
    const int kind = idx / 1056, rem = idx % 1056, b = rem / 528, rem2 = rem % 528, cs = rem2 >> 2, h = rem2 & 3;
    if (pass == 3 && last && cs < 4) return;
    const int DK = kind ? 48 : 64, DV = kind ? 96 : 64;
    const int qoff = kind ? 1024 + 48 * h : 64 * h, koff = kind ? 1216 + 48 * h : 256 + 64 * h, voff = kind ? 1408 + 96 * h : 512 + 64 * h, goff = kind ? 1792 + 96 * h : 768 + 64 * h;
    const int ycol = kind ? 256 + 96 * h : 64 * h;
    const int row0 = chunk_row0(b, cs);
    const int chain = ((kind * 2 + b) * 4 + h) * 2;
    const bf16_t* U = (const bf16_t*)(p.ws + (unsigned)opaque((int)WS_U));
    bf16_t* Y = (bf16_t*)(p.ws + (unsigned)opaque((int)WS_Y));
    bf16_t* Sf = kind ? (bf16_t*)(p.ws + (unsigned)opaque((int)WS_SGLA)) + ((size_t)(chain - 16) * NCH + cs) * 4608 : (bf16_t*)(p.ws + (unsigned)opaque((int)WS_SRET)) + ((size_t)chain * NCH + cs) * 4096;
    bf16_t* Sb = Sf + (size_t)NCH * (kind ? 4608 : 4096);
    float* dec = (float*)(p.ws + (unsigned)opaque((int)WS_DEC)) + ((size_t)chain * NCH + cs) * 64;
    LAS float* cumf = (LAS float*)lds; LAS float* cumb = cumf + 4096;
    LAS bf16_t* QF = (LAS bf16_t*)(lds + 32768); LAS bf16_t* QB = QF + 64 * LP; LAS bf16_t* KF = QB + 64 * LP; LAS bf16_t* KB = KF + 64 * LP;
    LAS bf16_t* VT = KB + 64 * LP; LAS bf16_t* PF = VT + 96 * LP; LAS bf16_t* PB = PF + 64 * LP; LAS bf16_t* STF = PB + 64 * LP; LAS bf16_t* STB = STF + 96 * LP;
    LAS float* red = (LAS float*)(STB + 96 * LP);
    if (kind == 0) {
        const float lgf = logf(1.f - exp2f(-5.f - (float)h)), lgb = logf(1.f - exp2f(-5.f - (float)(3 - h)));
        for (int e = tid; e < 4096; e += 512) { const int i = e >> 6; cumf[e] = (float)(i + 1) * lgf; cumb[e] = (float)(64 - i) * lgb; }
    } else {
        const float* wa2f = p.in[opaque(12)] + l * 16 * 192 + h * 48; const float* baf = p.in[opaque(13)] + l * 192 + h * 48;
        const float* wa2b = p.in[opaque(14)] + l * 16 * 192 + h * 48; const float* bab = p.in[opaque(15)] + l * 192 + h * 48;
        LAS bf16_t* LR = (LAS bf16_t*)(lds + 32768); LAS bf16_t* WtF = LR + 64 * 40; LAS bf16_t* WtB = WtF + 48 * 40; LAS float* SEG = (LAS float*)(WtB + 48 * 40);
        if (tid < 256) { const int i = tid >> 2, ch = tid & 3; *(LAS u32x4*)(LR + i * 40 + ch * 8) = *(const u32x4*)(U + (size_t)(row0 + i) * NU + 2176 + ch * 8); }
        for (int e = tid; e < 48 * 32; e += 512) { const int d = e % 48, k = e / 48; WtF[d * 40 + k] = k < 16 ? f2bf(wa2f[k * 192 + d]) : (bf16_t)0; WtB[d * 40 + k] = k >= 16 ? f2bf(wa2b[(k - 16) * 192 + d]) : (bf16_t)0; }
        for (int e = tid; e < 64 * 16; e += 512) { const int i = e >> 4, d = 48 + (e & 15); cumf[i * 64 + d] = 0.f; cumb[i * 64 + d] = 0.f; }
        LBAR();
        { const int dirA = w >> 2, mtA = w & 3; const LAS bf16_t* Wt = dirA ? WtB : WtF; LAS float* cu = dirA ? cumb : cumf; const float* bia = dirA ? bab : baf;
#pragma unroll
          for (int nt = 0; nt < 3; ++nt) { f32x4 a = {0.f, 0.f, 0.f, 0.f}; a = mma_tile<32>(LR + mtA * 16 * 40, 40, Wt + nt * 16 * 40, 40, a, r, q); const float bz = bia[nt * 16 + r];
#pragma unroll
              for (int j = 0; j < 4; ++j) cu[(mtA * 16 + q * 4 + j) * 64 + nt * 16 + r] = logsig_(a[j] + bz) * 0.0625f; } }
        LBAR();
        { const int d = tid & 63, sg = tid >> 6; float vf[8], vb[8]; float rf = 0.f, rb = 0.f;
#pragma unroll
          for (int j = 0; j < 8; ++j) { rf += cumf[(sg * 8 + j) * 64 + d]; vf[j] = rf; }
#pragma unroll
          for (int j = 7; j >= 0; --j) { rb += cumb[(sg * 8 + j) * 64 + d]; vb[j] = rb; }
          SEG[sg * 64 + d] = rf; SEG[512 + sg * 64 + d] = rb;
          LBAR();
          float of = 0.f, ob = 0.f;
#pragma unroll
          for (int g = 0; g < 8; ++g) { if (g < sg) of += SEG[g * 64 + d]; if (g > sg) ob += SEG[512 + g * 64 + d]; }
#pragma unroll
          for (int j = 0; j < 8; ++j) { cumf[(sg * 8 + j) * 64 + d] = vf[j] + of; cumb[(sg * 8 + j) * 64 + d] = vb[j] + ob; } }
    }
    LBAR();
    const bool rope = (kind == 0) && (cs >= 4);
    const float qs = kind ? 0.14433756729740643f : 1.f, ks = kind ? 1.f : 0.125f;
    for (int e = tid; e < 2048; e += 512) {
        const int i = e >> 5, pp = e & 31, d1 = pp < 16 ? pp : pp + 16, d2 = d1 + 16;
        const bf16_t* ur = U + (size_t)(row0 + i) * NU;
        float q1 = d1 < DK ? bf2f(ur[qoff + d1]) : 0.f, q2 = d2 < DK ? bf2f(ur[qoff + d2]) : 0.f;
        float k1 = d1 < DK ? bf2f(ur[koff + d1]) : 0.f, k2 = d2 < DK ? bf2f(ur[koff + d2]) : 0.f;
        if (rope) { const float pos = pp < 16 ? (float)(cs - 4) : (float)i; const float ang = pos * exp2f(-(float)(pp & 15) * 0.8304820237218406f);
            const float sn = __sinf(ang), cn = __cosf(ang);
            const float a = q1 * cn - q2 * sn, bq = q1 * sn + q2 * cn, c = k1 * cn - k2 * sn, dk_ = k1 * sn + k2 * cn; q1 = a; q2 = bq; k1 = c; k2 = dk_; }
        q1 *= qs; q2 *= qs; k1 *= ks; k2 *= ks;
        const float cf1 = cumf[i * 64 + d1], cf2 = cumf[i * 64 + d2], cb1 = cumb[i * 64 + d1], cb2 = cumb[i * 64 + d2];
        if (pass == 3) {
            QF[i * LP + d1] = f2bf(q1 * __expf(cf1)); QF[i * LP + d2] = f2bf(q2 * __expf(cf2));
            QB[i * LP + d1] = f2bf(q1 * __expf(cb1)); QB[i * LP + d2] = f2bf(q2 * __expf(cb2));
            KF[i * LP + d1] = f2bf(k1 * __expf(-cf1)); KF[i * LP + d2] = f2bf(k2 * __expf(-cf2));
            KB[i * LP + d1] = f2bf(k1 * __expf(-cb1)); KB[i * LP + d2] = f2bf(k2 * __expf(-cb2));
        } else {
            const float ef1 = cumf[63 * 64 + d1], ef2 = cumf[63 * 64 + d2], eb1 = cumb[d1], eb2 = cumb[d2];
            KF[d1 * LP + i] = f2bf(k1 * __expf(ef1 - cf1)); KF[d2 * LP + i] = f2bf(k2 * __expf(ef2 - cf2));
            KB[d1 * LP + i] = f2bf(k1 * __expf(eb1 - cb1)); KB[d2 * LP + i] = f2bf(k2 * __expf(eb2 - cb2));
        }
    }
    { const int nvb = DV >> 3;
      for (int e = tid; e < 64 * nvb; e += 512) { const int j = e / nvb, vb = e % nvb;
          const bf16x8 vv = *(const bf16x8*)(U + (size_t)(row0 + j) * NU + voff + vb * 8);
#pragma unroll
          for (int t = 0; t < 8; ++t) VT[(vb * 8 + t) * LP + j] = (bf16_t)vv[t]; } }
    if (pass == 1) {
        LBAR();
        const int dir = w >> 2, nt = w & 3; const LAS bf16_t* KH = dir ? KB : KF; bf16_t* So = dir ? Sb : Sf; const int d = nt * 16 + r;
        for (int mt = 0; mt < (DV >> 4); ++mt) { f32x4 acc = {0.f, 0.f, 0.f, 0.f}; acc = mma_tile<64>(VT + mt * 16 * LP, LP, KH + nt * 16 * LP, LP, acc, r, q);
            if (d < DK) {
#pragma unroll
                for (int j = 0; j < 4; ++j) So[(mt * 16 + q * 4 + j) * DK + d] = f2bf(acc[j]); } }
        if (tid < 64) dec[tid] = cumf[63 * 64 + tid]; else if (tid < 128) dec[NCH * 64 + tid - 64] = cumb[tid - 64];
        LBAR();
        return;
    }
    for (int e = tid; e < DV * 8; e += 512) { const int v = e >> 3, db = e & 7; u32x4 zf = {0u, 0u, 0u, 0u}, zb = zf;
        if (db * 8 < DK) { zf = *(const u32x4*)(Sf + v * DK + db * 8); zb = *(const u32x4*)(Sb + v * DK + db * 8); }
        *(LAS u32x4*)(STF + v * LP + db * 8) = zf; *(LAS u32x4*)(STB + v * LP + db * 8) = zb; }
    LBAR();
    { const int dir = w >> 2, rb = w & 3; const LAS bf16_t* Qd = dir ? QB : QF; const LAS bf16_t* Kd = dir ? KB : KF; LAS bf16_t* Pd = dir ? PB : PF;
#pragma unroll
      for (int nt = 0; nt < 4; ++nt) { f32x4 acc = {0.f, 0.f, 0.f, 0.f}; acc = mma_tile<64>(Qd + rb * 16 * LP, LP, Kd + nt * 16 * LP, LP, acc, r, q);
#pragma unroll
          for (int j = 0; j < 4; ++j) { const int i = rb * 16 + q * 4 + j, jj = nt * 16 + r; const bool keep = dir ? (jj >= i) : (jj <= i); Pd[i * LP + jj] = f2bf(keep ? acc[j] : 0.f); } } }
    LBAR();
    const int rb = w & 3, ch = w >> 2, NT = DV >> 5;
    f32x4 acc[3];
#pragma unroll
    for (int nt = 0; nt < 3; ++nt) { acc[nt] = (f32x4){0.f, 0.f, 0.f, 0.f};
        if (nt < NT) { const int v0 = (ch * NT + nt) * 16;
            acc[nt] = mma_tile<64>(PF + rb * 16 * LP, LP, VT + v0 * LP, LP, acc[nt], r, q);
            acc[nt] = mma_tile<64>(PB + rb * 16 * LP, LP, VT + v0 * LP, LP, acc[nt], r, q);
            acc[nt] = mma_tile<64>(QF + rb * 16 * LP, LP, STF + v0 * LP, LP, acc[nt], r, q);
            acc[nt] = mma_tile<64>(QB + rb * 16 * LP, LP, STB + v0 * LP, LP, acc[nt], r, q); } }
    float s1[4], s2[4];
#pragma unroll
    for (int j = 0; j < 4; ++j) { s1[j] = acc[0][j] + acc[1][j] + acc[2][j]; s2[j] = acc[0][j] * acc[0][j] + acc[1][j] * acc[1][j] + acc[2][j] * acc[2][j];
        s1[j] = row16_sum(s1[j]); s2[j] = row16_sum(s2[j]); }
    if (r == 0) {
#pragma unroll
        for (int j = 0; j < 4; ++j) { red[((rb * 2 + ch) * 16 + q * 4 + j) * 2] = s1[j]; red[((rb * 2 + ch) * 16 + q * 4 + j) * 2 + 1] = s2[j]; } }
    LBAR();
    const float invdv = 1.f / (float)DV;
#pragma unroll
    for (int j = 0; j < 4; ++j) { const int rr = q * 4 + j;
        const float t1 = red[((rb * 2) * 16 + rr) * 2] + red[((rb * 2 + 1) * 16 + rr) * 2], t2 = red[((rb * 2) * 16 + rr) * 2 + 1] + red[((rb * 2 + 1) * 16 + rr) * 2 + 1];
        const float mean = t1 * invdv; float mu, rstd;
        if (kind == 0) { mu = mean; rstd = rsqrtf(fmaxf(t2 * invdv - mean * mean, 0.f) + 1e-5f); } else { mu = 0.f; rstd = rsqrtf(t2 * invdv + 1e-5f); }
        const int row = row0 + rb * 16 + rr;
#pragma unroll
        for (int nt = 0; nt < 3; ++nt) if (nt < NT) { const int v = (ch * NT + nt) * 16 + r;
            const float nw = kind ? p.in[opaque(16)][l * 96 + v] : p.in[opaque(11)][l * 256 + h * 64 + v];
            const float g = bf2f(U[(size_t)row * NU + goff + v]);
            Y[(size_t)row * D + ycol + v] = f2bf((acc[nt][j] - mu) * rstd * nw * siluf_(g)); } }
    LBAR();
}

__device__ __forceinline__ void la_scan(const Params& p, int vb, int nvb) {
    typedef float f32x2s __attribute__((ext_vector_type(2)));
    for (int e2 = vb * 512 + vopaque((int)threadIdx.x); e2 < 32 * 2304; e2 += nvb * 512) {
        const int chain = e2 / 2304, el = (e2 % 2304) * 2, kind = chain >> 4, dir = chain & 1;
        if (kind == 0 && el >= 4096) continue;
        const int DK = kind ? 48 : 64, d = el % DK, esz2 = kind ? 2304 : 2048;
        unsigned* S = (unsigned*)((kind ? (bf16_t*)(p.ws + (unsigned)opaque((int)WS_SGLA)) + (size_t)(chain - 16) * NCH * 4608 : (bf16_t*)(p.ws + (unsigned)opaque((int)WS_SRET)) + (size_t)chain * NCH * 4096) + el);
        const float* dec = (const float*)(p.ws + (unsigned)opaque((int)WS_DEC)) + (size_t)chain * NCH * 64 + d;
        float a0 = 0.f, a1 = 0.f;
        for (int s = 0; s < NCH; s += 12) {
            int sl[12]; unsigned t[12]; f32x2s dc[12];
#pragma unroll
            for (int u = 0; u < 12; ++u) { const int ss = s + u; sl[u] = dir ? (ss < 4 ? 3 - ss : 135 - ss) : ss; t[u] = S[(size_t)sl[u] * esz2]; dc[u] = *(const f32x2s*)(dec + sl[u] * 64); }
#pragma unroll
            for (int u = 0; u < 12; ++u) { S[(size_t)sl[u] * esz2] = pk2(a0, a1); a0 = a0 * __expf(dc[u].x) + __uint_as_float(t[u] << 16); a1 = a1 * __expf(dc[u].y) + __uint_as_float(t[u] & 0xffff0000u); }
        }
    }
}

__device__ __forceinline__ float rw_conv(const bf16_t* U, const float* cw, int row, int t, int tmax, int col) {
    const bf16_t* uc = U + (size_t)row * NU + 2208 + col; float x = cw[1472 + col] * bf2f(uc[0]);
    if (t > 0) x += cw[col] * bf2f(uc[-NU]);
    if (t + 1 < tmax) x += cw[2944 + col] * bf2f(uc[NU]);
    return x;
}
__device__ __forceinline__ float lwdec_(float z) { const float sp = (-z > 20.f) ? -z : __logf(1.f + __expf(-z)); return -__expf(-sp - 0.5f); }
__device__ __forceinline__ float tanh_(float x) { return 1.f - 2.f / (__expf(2.f * x) + 1.f); }
__device__ __forceinline__ u32x2 pack4(const f32x4 a) { u32x2 o; o.x = pk2(a[0], a[1]); o.y = pk2(a[2], a[3]); return o; }
__device__ __forceinline__ f32x4 unpack4(const u32x2 v) { f32x4 a; a[0] = __uint_as_float(v.x << 16); a[1] = __uint_as_float(v.x & 0xffff0000u); a[2] = __uint_as_float(v.y << 16); a[3] = __uint_as_float(v.y & 0xffff0000u); return a; }

typedef _Float16 half8_t __attribute__((ext_vector_type(8)));
typedef _Float16 half2_t __attribute__((ext_vector_type(2)));
__device__ __forceinline__ float clamph(float x) { return fminf(fmaxf(x, -60000.f), 60000.f); }
__device__ __forceinline__ bf16_t f2h(float f);
__device__ __forceinline__ unsigned pk2h(float lo, float hi) { return (unsigned)f2h(lo) | ((unsigned)f2h(hi) << 16); }
__device__ __forceinline__ bf16_t f2h(float f) { return __builtin_bit_cast(unsigned short, (_Float16)f); }
__device__ __forceinline__ u32x2 pack4h(const f32x4 a) { u32x2 o; o.x = pk2h(a[0], a[1]); o.y = pk2h(a[2], a[3]); return o; }
__device__ __forceinline__ float h2f_(unsigned short b) { return (float)__builtin_bit_cast(_Float16, b); }
__device__ __forceinline__ f32x4 unpack4h(const u32x2 v) { f32x4 a; a[0] = h2f_((unsigned short)(v.x & 0xffffu)); a[1] = h2f_((unsigned short)(v.x >> 16)); a[2] = h2f_((unsigned short)(v.y & 0xffffu)); a[3] = h2f_((unsigned short)(v.y >> 16)); return a; }
__device__ __forceinline__ float expc_(float x) { return __expf(fminf(x, 8.f)); }
template <int K> __device__ __forceinline__ f32x4 mma_tile_h(const LAS bf16_t* A, int lda, const LAS bf16_t* Bt, int ldb, f32x4 acc, int r, int q) {
#pragma unroll
    for (int k0 = 0; k0 < K; k0 += 32) {
        const bf16x8 a = *(const LAS bf16x8*)(A + r * lda + k0 + q * 8);
        const bf16x8 b = *(const LAS bf16x8*)(Bt + r * ldb + k0 + q * 8);
        acc = __builtin_amdgcn_mfma_f32_16x16x32_f16(__builtin_bit_cast(half8_t, a), __builtin_bit_cast(half8_t, b), acc, 0, 0, 0);
    }
    return acc;
}
__device__ __forceinline__ void w2t_phase(const Params& p, int l, int bid, int G) {
    bf16_t* o = (bf16_t*)(p.ws + (unsigned)opaque((int)WS_W2T));
    for (int e = bid * 512 + vopaque((int)threadIdx.x); e < 6 * 20480; e += G * 512) { const int h = e / 20480, x = e % 20480; float v;
        if (x < 12288) { const int which = x >> 12, hd = (x >> 6) & 63, rr = x & 63; const float* src = which == 0 ? p.in[opaque(23)] : which == 1 ? p.in[opaque(19)] : p.in[opaque(21)]; v = src[(size_t)l * 64 * 384 + rr * 384 + h * 64 + hd]; }
        else { const int y = x - 12288, hd = y >> 7, rr = y & 127; v = p.in[opaque(24)][(size_t)l * 128 * 384 + rr * 384 + h * 64 + hd]; }
        o[e] = f2h(v); }
}

__device__ __forceinline__ void lr_pre_phase(const Params& p, int l, int bid, int G) {
    bf16_t* U = (bf16_t*)(p.ws + (unsigned)opaque((int)WS_U)); bf16_t* ACT = (bf16_t*)(p.ws + (unsigned)opaque((int)WS_ACT));
    const float* cw = p.in[opaque(17)] + l * 3 * 1472;
    for (int e = bid * 512 + vopaque((int)threadIdx.x); e < MALL * 40; e += G * 512) { const int m = e / 40, c0 = (e % 40) * 8, col = 1152 + c0;
        const int t = m < MLAT ? (m & (SEQ - 1)) : ((m - MLAT) & (CTXL - 1)), tmax = m < MLAT ? SEQ : CTXL;
        const bf16_t* uc = U + (size_t)m * NU + 2208 + col;
        const bf16x8 zz = {0, 0, 0, 0, 0, 0, 0, 0};
        const bf16x8 u0 = *(const bf16x8*)uc, um = (t > 0) ? *(const bf16x8*)(uc - NU) : zz, up = (t + 1 < tmax) ? *(const bf16x8*)(uc + NU) : zz;
        float x[8];
#pragma unroll
        for (int hh = 0; hh < 2; ++hh) { const f32x4 wm = *(const f32x4*)(cw + col + 4 * hh), w0 = *(const f32x4*)(cw + 1472 + col + 4 * hh), wp = *(const f32x4*)(cw + 2944 + col + 4 * hh);
#pragma unroll
            for (int j = 0; j < 4; ++j) x[4 * hh + j] = wm[j] * bf2f((bf16_t)um[4 * hh + j]) + w0[j] * bf2f((bf16_t)u0[4 * hh + j]) + wp[j] * bf2f((bf16_t)up[4 * hh + j]); }
        if (c0 < 128) {
#pragma unroll
            for (int j = 0; j < 8; ++j) x[j] = tanh_(x[j]); }
        else if (c0 >= 192) {
#pragma unroll
            for (int j = 0; j < 8; ++j) x[j] = sigmoidf_(x[j]); }
        u32x4 o; o.x = pk2h(x[0], x[1]); o.y = pk2h(x[2], x[3]); o.z = pk2h(x[4], x[5]); o.w = pk2h(x[6], x[7]);
        bf16_t* dst = c0 < 128 ? U + (size_t)m * NU + 3680 + c0 : ACT + (size_t)m * 192 + c0 - 128;
        *(u32x4*)dst = o; }
}

__device__ __forceinline__ void ldfrag2(const LAS bf16_t* M, int row0, int r, int q, bf16x8 (&f)[2]) { f[0] = *(const LAS bf16x8*)(M + (row0 + r) * LP + q * 8); f[1] = *(const LAS bf16x8*)(M + (row0 + r) * LP + 32 + q * 8); }
__device__ __forceinline__ f32x4 mm2h(const bf16x8 (&a)[2], const bf16x8 (&b)[2], f32x4 acc) {
    acc = __builtin_amdgcn_mfma_f32_16x16x32_f16(__builtin_bit_cast(half8_t, a[0]), __builtin_bit_cast(half8_t, b[0]), acc, 0, 0, 0);
    acc = __builtin_amdgcn_mfma_f32_16x16x32_f16(__builtin_bit_cast(half8_t, a[1]), __builtin_bit_cast(half8_t, b[1]), acc, 0, 0, 0); return acc; }
constexpr int SLB = 9216;
#define SLOT(n) ((LAS bf16_t*)(lds + (n) * SLB))
template <bool PC> __device__ __forceinline__ void rw_item(const Params& p, int l, int idx, bool last, LAS unsigned char* lds) {
    const int tid = vopaque((int)threadIdx.x), lane = tid & 63, w = tid >> 6, r = lane & 15, q = lane >> 4;
    const int b = idx / 792, rem = idx % 792, cs = rem / 6, h = rem % 6;
    if (PC && last && cs < 4) return;
    const int row0 = chunk_row0(b, cs), t0 = cs < 4 ? cs * 64 : (cs - 4) * 64, tmax = cs < 4 ? CTXL : SEQ;
    const bf16_t* U = (const bf16_t*)(p.ws + (unsigned)opaque((int)WS_U));
    const float* cw = p.in[opaque(17)] + l * 3 * 1472;
    float ur[10], uk[10], uv[10];
#pragma unroll
    for (int jr = 0; jr < 10; ++jr) { const int i = w * 8 + jr - 1, t = t0 + i; const bool ok = (t >= 0) && (t < tmax);
        const bf16_t* up_ = U + (size_t)(row0 + (ok ? i : 0)) * NU + 2208 + h * 64 + lane;
        const bf16_t x0 = up_[0], x1 = up_[384], x2 = up_[768];
        ur[jr] = ok ? bf2f(x0) : 0.f; uk[jr] = ok ? bf2f(x1) : 0.f; uv[jr] = ok ? bf2f(x2) : 0.f; }
    const int hc = l * 384 + h * 64 + lane;
    const float a0v = p.in[opaque(22)][hc], w0fv = p.in[opaque(18)][hc], w0bv = p.in[opaque(20)][hc], kkv = p.in[opaque(25)][hc], kav = p.in[opaque(26)][hc], rkv = p.in[opaque(27)][hc];
    u32x4 hv0 = {0u, 0u, 0u, 0u}, hv1 = hv0;
    if (PC) { const bf16_t* Nb = (const bf16_t*)(p.ws + (unsigned)opaque((int)WS_RWN)) + ((size_t)((b * 6 + h) * 2) * NCH + cs) * 4096 + (tid >> 3) * 64 + (tid & 7) * 8;
        hv0 = *(const u32x4*)Nb; hv1 = *(const u32x4*)(Nb + (size_t)NCH * 4096); }
    LAS float* ZA = (LAS float*)lds; LAS float* ZF = ZA + 4096; LAS float* ZB = ZF + 4096; LAS float* ZG = ZB + 4096;
    LAS bf16_t* LAa = (LAS bf16_t*)(lds + 65536); LAS bf16_t* LWF = LAa + 64 * LP; LAS bf16_t* LWB = LWF + 64 * LP; LAS bf16_t* LGs = LWB + 64 * LP;
    LAS bf16_t* A2T = LGs + 64 * 136; LAS bf16_t* WFT = A2T + 64 * LP; LAS bf16_t* WBT = WFT + 64 * LP; LAS bf16_t* G2T = WBT + 64 * LP;
    { constexpr int NG = (PC ? 320 : 192) / 8;
      const bf16_t* ACT = (const bf16_t*)(p.ws + (unsigned)opaque((int)WS_ACT));
      for (int e = tid; e < 64 * NG; e += 512) { const int i = e / NG, c0 = (e % NG) * 8;
          const u32x4 v = c0 < 128 ? *(const u32x4*)(U + (size_t)(row0 + i) * NU + 3680 + c0) : *(const u32x4*)(ACT + (size_t)(row0 + i) * 192 + c0 - 128);
          LAS bf16_t* dst = c0 < 64 ? LWF + i * LP + c0 : c0 < 128 ? LWB + i * LP + c0 - 64 : c0 < 192 ? LAa + i * LP + c0 - 128 : LGs + i * 136 + c0 - 192;
          *(LAS u32x4*)dst = v; } }
    { const bf16_t* wt = (const bf16_t*)(p.ws + (unsigned)opaque((int)WS_W2T)) + (size_t)h * 20480; const int row = tid >> 3, ch = tid & 7;
      *(LAS u32x4*)(A2T + row * LP + ch * 8) = *(const u32x4*)(wt + row * 64 + ch * 8);
      *(LAS u32x4*)(WFT + row * LP + ch * 8) = *(const u32x4*)(wt + 4096 + row * 64 + ch * 8);
      *(LAS u32x4*)(WBT + row * LP + ch * 8) = *(const u32x4*)(wt + 8192 + row * 64 + ch * 8);
      if (PC) for (int e = tid; e < 1024; e += 512) { const int rw = e >> 4, c2 = e & 15; *(LAS u32x4*)(G2T + rw * 136 + c2 * 8) = *(const u32x4*)(wt + 12288 + rw * 128 + c2 * 8); } }
    LBAR();
#pragma unroll
    for (int tt = 0; tt < 2; ++tt) { const int t = w * 2 + tt, mt = t >> 2, nt = t & 3, o = (mt * 16 + q * 4) * 64 + nt * 16 + r;
        f32x4 a = {0.f, 0.f, 0.f, 0.f}; a = mma_tile_h<64>(LAa + mt * 16 * LP, LP, A2T + nt * 16 * LP, LP, a, r, q);
#pragma unroll
        for (int j = 0; j < 4; ++j) ZA[o + j * 64] = a[j];
        a = (f32x4){0.f, 0.f, 0.f, 0.f}; a = mma_tile_h<64>(LWF + mt * 16 * LP, LP, WFT + nt * 16 * LP, LP, a, r, q);
#pragma unroll
        for (int j = 0; j < 4; ++j) ZF[o + j * 64] = a[j];
        a = (f32x4){0.f, 0.f, 0.f, 0.f}; a = mma_tile_h<64>(LWB + mt * 16 * LP, LP, WBT + nt * 16 * LP, LP, a, r, q);
#pragma unroll
        for (int j = 0; j < 4; ++j) ZB[o + j * 64] = a[j];
        if (PC) { a = (f32x4){0.f, 0.f, 0.f, 0.f}; a = mma_tile_h<128>(LGs + mt * 16 * 136, 136, G2T + nt * 16 * 136, 136, a, r, q);
#pragma unroll
            for (int j = 0; j < 4; ++j) ZG[o + j * 64] = a[j]; } }
    LBAR();
    float R_[8], K2[8], V_[8], KN[8], BE[8], LF[8], LB[8], GG[8], BO[8];
    {
      const int cc = h * 64 + lane;
      const float cr0 = cw[cc], cr1 = cw[1472 + cc], cr2 = cw[2944 + cc], ck0 = cw[384 + cc], ck1 = cw[1472 + 384 + cc], ck2 = cw[2944 + 384 + cc], cv0 = cw[768 + cc], cv1 = cw[1472 + 768 + cc], cv2 = cw[2944 + 768 + cc];
#pragma unroll
      for (int jj = 0; jj < 8; ++jj) { const int i = w * 8 + jj;
          const float rv = cr0 * ur[jj] + cr1 * ur[jj + 1] + cr2 * ur[jj + 2], kv = ck0 * uk[jj] + ck1 * uk[jj + 1] + ck2 * uk[jj + 2], vv = cv0 * uv[jj] + cv1 * uv[jj + 1] + cv2 * uv[jj + 2];
          const float a = sigmoidf_(a0v + ZA[i * 64 + lane]);
          LF[jj] = lwdec_(w0fv + ZF[i * 64 + lane]); LB[jj] = lwdec_(w0bv + ZB[i * 64 + lane]);
          float kk = kv * kkv; const float n2 = wave_sum(kk * kk); kk *= rsqrtf(fmaxf(n2, 1e-24f));
          const float k2 = kv * (1.f + (a - 1.f) * kav);
          R_[jj] = rv; K2[jj] = k2; V_[jj] = vv; KN[jj] = kk; BE[jj] = kk * a;
          if (PC) { GG[jj] = ZG[i * 64 + lane]; BO[jj] = wave_sum(rv * k2 * rkv) * vv; } else { GG[jj] = 0.f; BO[jj] = 0.f; } } }
    LBAR();
    LAS float* TOT = (LAS float*)(lds + 17 * SLB);
    LAS bf16_t* AB = SLOT(0); LAS bf16_t* BBm = SLOT(1); LAS bf16_t* KBm = SLOT(2); LAS bf16_t* S3 = SLOT(3); LAS bf16_t* VT = SLOT(4); LAS bf16_t* S5 = SLOT(5);
    LAS bf16_t* XP = SLOT(6); LAS bf16_t* XPT = SLOT(7); LAS bf16_t* XST = SLOT(8); LAS bf16_t* YP = SLOT(9); LAS bf16_t* YPT = SLOT(10); LAS bf16_t* YST = SLOT(11);
    LAS bf16_t* AAK = SLOT(12); LAS bf16_t* ARB = SLOT(13); LAS bf16_t* ARK = SLOT(14);
    LAS bf16_t* XT = PC ? SLOT(15) : SLOT(13);
    LAS bf16_t* UT = PC ? SLOT(16) : SLOT(15);
    f32x4 Of[2] = {{0.f, 0.f, 0.f, 0.f}, {0.f, 0.f, 0.f, 0.f}};
    const int mtw = w >> 1, ntw = (w & 1) * 2;
    for (int dir = 0; dir < 2; ++dir) {
        const int cd = ((b * 6 + h) * 2 + dir) * NCH + cs;
        const bool useT = PC && dir == 0;
        bf16_t* Mg = (bf16_t*)(p.ws + (unsigned)opaque((int)WS_RWM)) + (size_t)cd * 4096; bf16_t* Ng = (bf16_t*)(p.ws + (unsigned)opaque((int)WS_RWN)) + (size_t)cd * 4096; float* Pg = (float*)(p.ws + (unsigned)opaque((int)WS_RWP)) + (size_t)cd * 64;
        float cum[8]; float run = 0.f;
        if (dir == 0) {
#pragma unroll
            for (int jj = 0; jj < 8; ++jj) { run += LF[jj]; cum[jj] = run; } }
        else {
#pragma unroll
            for (int jj = 7; jj >= 0; --jj) { run += LB[jj]; cum[jj] = run; } }
        TOT[w * 64 + lane] = run;
        LBAR();
        float off = 0.f, cumtot = 0.f;
#pragma unroll
        for (int ww = 0; ww < 8; ++ww) { const float tv = TOT[ww * 64 + lane]; cumtot += tv; if (dir == 0 ? (ww < w) : (ww > w)) off += tv; }
        LAS float* CR = TOT + 512;
        if (dir == 0 ? (w == 3) : (w == 4)) CR[lane] = (dir == 0 ? cum[7] : cum[0]) + off;
        LBAR();
        const float cref = CR[lane];
#pragma unroll
        for (int jj = 0; jj < 8; ++jj) { const int i = w * 8 + jj, pp = dir ? 63 - i : i; const float lw = dir ? LB[jj] : LF[jj], cj = cum[jj] + off;
            const float al = -KN[jj] * expc_(cj - lw - cref), einv = expc_(cref - cj);
            AB[pp * LP + lane] = f2h(al); BBm[pp * LP + lane] = f2h(BE[jj] * einv); KBm[pp * LP + lane] = f2h(K2[jj] * einv);
            VT[lane * LP + pp] = f2h(V_[jj]);
            if (PC) S3[pp * LP + lane] = f2h(R_[jj] * expc_(cj - cref));
            else { const float ee = __expf(cumtot - cj); S3[lane * LP + pp] = f2h(BE[jj] * ee); S5[lane * LP + pp] = f2h(K2[jj] * ee); XT[lane * LP + pp] = f2h(al); } }
        if (useT) { const int row = tid >> 3, ch = tid & 7; *(LAS u32x4*)(XP + row * LP + ch * 8) = *(const u32x4*)((const bf16_t*)(p.ws + (unsigned)opaque((int)WS_Y)) + (size_t)(row0 + row) * D + 640 + h * 64 + ch * 8); }
        if (PC) { const int row = tid >> 3, ch = tid & 7; const u32x4 hv = dir ? hv1 : hv0;
            const f32x4 h0 = unpack4h((u32x2){hv.x, hv.y}), h1 = unpack4h((u32x2){hv.z, hv.w}); const f32x4 e0 = *(const LAS f32x4*)(CR + ch * 8), e1 = *(const LAS f32x4*)(CR + ch * 8 + 4);
            f32x4 g0, g1;
#pragma unroll
            for (int j = 0; j < 4; ++j) { g0[j] = h0[j] * __expf(e0[j]); g1[j] = h1[j] * __expf(e1[j]); }
            const u32x2 p0 = pack4h(g0), p1 = pack4h(g1); *(LAS u32x4*)(S5 + row * LP + ch * 8) = (u32x4){p0.x, p0.y, p1.x, p1.y}; }
        LBAR();
        { bf16x8 fA[2], fR[2]; ldfrag2(AB, mtw * 16, r, q, fA); if (PC) ldfrag2(S3, mtw * 16, r, q, fR);
#pragma unroll
          for (int tt = 0; tt < 2; ++tt) { const int nt = ntw + tt, pp0 = mtw * 16 + q * 4, ss = nt * 16 + r;
            bf16x8 fB[2], fK[2]; ldfrag2(BBm, nt * 16, r, q, fB); ldfrag2(KBm, nt * 16, r, q, fK);
            f32x4 a;
            if (!useT) { a = mm2h(fA, fB, (f32x4){0.f, 0.f, 0.f, 0.f});
#pragma unroll
                for (int j = 0; j < 4; ++j) { a[j] = (ss < pp0 + j) ? a[j] : 0.f; XP[(pp0 + j) * LP + ss] = f2h(a[j]); }
                *(LAS u32x2*)(XPT + ss * LP + pp0) = pack4h(a);
#pragma unroll
                for (int j = 0; j < 4; ++j) a[j] = (ss == pp0 + j) ? 1.f : a[j];
                *(LAS u32x2*)(YST + ss * LP + pp0) = pack4h(a); }
            a = mm2h(fA, fK, (f32x4){0.f, 0.f, 0.f, 0.f});
#pragma unroll
            for (int j = 0; j < 4; ++j) AAK[(pp0 + j) * LP + ss] = f2h((ss < pp0 + j) ? a[j] : 0.f);
            if (PC) {
                a = mm2h(fR, fB, (f32x4){0.f, 0.f, 0.f, 0.f});
#pragma unroll
                for (int j = 0; j < 4; ++j) ARB[(pp0 + j) * LP + ss] = f2h((ss <= pp0 + j) ? a[j] : 0.f);
                a = mm2h(fR, fK, (f32x4){0.f, 0.f, 0.f, 0.f});
#pragma unroll
                for (int j = 0; j < 4; ++j) ARK[(pp0 + j) * LP + ss] = f2h((ss <= pp0 + j) ? a[j] : 0.f); } } }
        LBAR();
        { bf16x8 fP[2], fAk[2], fAb[2]; if (!useT) ldfrag2(XP, mtw * 16, r, q, fP); else { fP[0] = (bf16x8){0,0,0,0,0,0,0,0}; fP[1] = fP[0]; } ldfrag2(AAK, mtw * 16, r, q, fAk); if (PC) ldfrag2(AB, mtw * 16, r, q, fAb);
#pragma unroll
          for (int tt = 0; tt < 2; ++tt) { const int nt = ntw + tt, pp0 = mtw * 16 + q * 4, ss = nt * 16 + r;
            bf16x8 fT[2], fV[2]; if (!useT) ldfrag2(XPT, nt * 16, r, q, fT); else { fT[0] = (bf16x8){0,0,0,0,0,0,0,0}; fT[1] = fT[0]; } ldfrag2(VT, nt * 16, r, q, fV);
            if (!useT) { const f32x4 c = mm2h(fP, fT, (f32x4){0.f, 0.f, 0.f, 0.f});
#pragma unroll
                for (int j = 0; j < 4; ++j) YP[(pp0 + j) * LP + ss] = f2h(c[j]);
                *(LAS u32x2*)(YPT + ss * LP + pp0) = pack4h(c); }
            f32x4 x = mm2h(fAk, fV, (f32x4){0.f, 0.f, 0.f, 0.f});
            if (PC) { bf16x8 fH[2]; ldfrag2(S5, nt * 16, r, q, fH); x = mm2h(fAb, fH, x); *(LAS u32x2*)(XT + ss * LP + pp0) = pack4h(x); }
            else *(LAS u32x2*)(XT + (64 + ss) * LP + pp0) = pack4h(x); } }
        LBAR();
        if (!useT) for (int k = 1; k <= 5; ++k) {
            LAS bf16_t* sP = (k & 1) ? YP : XP; LAS bf16_t* sPT = (k & 1) ? YPT : XPT; LAS bf16_t* sST = (k & 1) ? YST : XST;
            LAS bf16_t* dP = (k & 1) ? XP : YP; LAS bf16_t* dPT = (k & 1) ? XPT : YPT; LAS bf16_t* dST = (k & 1) ? XST : YST;
            bf16x8 fP[2]; ldfrag2(sP, mtw * 16, r, q, fP);
#pragma unroll
            for (int tt = 0; tt < 2; ++tt) { const int nt = ntw + tt, pp0 = mtw * 16 + q * 4, ss = nt * 16 + r;
                bf16x8 fS[2]; ldfrag2(sST, nt * 16, r, q, fS);
                f32x4 a = unpack4h(*(const LAS u32x2*)(sST + ss * LP + pp0));
                a = mm2h(fP, fS, a);
                if (k < 5) {
                    *(LAS u32x2*)(dST + ss * LP + pp0) = pack4h(a);
                    bf16x8 fT[2]; ldfrag2(sPT, nt * 16, r, q, fT);
                    const f32x4 c = mm2h(fP, fT, (f32x4){0.f, 0.f, 0.f, 0.f});
#pragma unroll
                    for (int j = 0; j < 4; ++j) dP[(pp0 + j) * LP + ss] = f2h(c[j]);
                    *(LAS u32x2*)(dPT + ss * LP + pp0) = pack4h(c);
                } else {
#pragma unroll
                    for (int j = 0; j < 4; ++j) dP[(pp0 + j) * LP + ss] = f2h(a[j]); } }
            LBAR();
        }
        if (!PC && dir == 0) { const int row = tid >> 3, ch = tid & 7; *(u32x4*)((bf16_t*)(p.ws + (unsigned)opaque((int)WS_Y)) + (size_t)(row0 + row) * D + 640 + h * 64 + ch * 8) = *(const LAS u32x4*)(XP + row * LP + ch * 8); }
        if (!PC) {
#pragma unroll
            for (int mt = 0; mt < 4; ++mt) { f32x4 a = {0.f, 0.f, 0.f, 0.f}; a = mma_tile_h<64>(XP + mt * 16 * LP, LP, XT + (w * 16) * LP, LP, a, r, q);
                *(LAS u32x2*)(UT + (w * 16 + r) * LP + mt * 16 + q * 4) = pack4h(a); }
            LBAR();
#pragma unroll
            for (int tt = 0; tt < 2; ++tt) { const int nt = ntw + tt;
                f32x4 a = {0.f, 0.f, 0.f, 0.f}; a = mma_tile_h<64>(S3 + mtw * 16 * LP, LP, UT + nt * 16 * LP, LP, a, r, q);
#pragma unroll
                for (int j = 0; j < 4; ++j) Mg[(mtw * 16 + q * 4 + j) * 64 + nt * 16 + r] = f2h(a[j] * __expf(CR[nt * 16 + r]));
                f32x4 n = {0.f, 0.f, 0.f, 0.f}; n = mma_tile_h<64>(S3 + mtw * 16 * LP, LP, UT + (64 + nt * 16) * LP, LP, n, r, q);
                n = mma_tile_h<64>(S5 + mtw * 16 * LP, LP, VT + nt * 16 * LP, LP, n, r, q);
                *(u32x2*)(Ng + (nt * 16 + r) * 64 + mtw * 16 + q * 4) = pack4h(n); }
            if (w == 0) Pg[lane] = __expf(cumtot);
            LBAR();
        } else {
            bf16x8 fTT[2]; ldfrag2(XP, mtw * 16, r, q, fTT);
#pragma unroll
            for (int tt = 0; tt < 2; ++tt) { const int nt = ntw + tt; bf16x8 fX[2]; ldfrag2(XT, nt * 16, r, q, fX); const f32x4 a = mm2h(fTT, fX, (f32x4){0.f, 0.f, 0.f, 0.f});
                *(LAS u32x2*)(UT + (nt * 16 + r) * LP + mtw * 16 + q * 4) = pack4h(a); }
            LBAR();
            f32x4 o[2];
            bf16x8 fRB[2], fARB[2], fARK[2]; ldfrag2(S3, mtw * 16, r, q, fRB); ldfrag2(ARB, mtw * 16, r, q, fARB); ldfrag2(ARK, mtw * 16, r, q, fARK);
#pragma unroll
            for (int tt = 0; tt < 2; ++tt) { const int nt = ntw + tt; bf16x8 fH[2], fU[2], fV[2]; ldfrag2(S5, nt * 16, r, q, fH); ldfrag2(UT, nt * 16, r, q, fU); ldfrag2(VT, nt * 16, r, q, fV);
                f32x4 a = mm2h(fRB, fH, (f32x4){0.f, 0.f, 0.f, 0.f}); a = mm2h(fARB, fU, a); a = mm2h(fARK, fV, a); o[tt] = a; }
            if (dir == 0) { Of[0] = o[0]; Of[1] = o[1]; LBAR(); }
            else {
                LBAR();
                LAS float* OS = (LAS float*)SLOT(6);
#pragma unroll
                for (int tt = 0; tt < 2; ++tt)
#pragma unroll
                    for (int j = 0; j < 4; ++j) OS[(mtw * 16 + q * 4 + j) * 64 + (ntw + tt) * 16 + r] = Of[tt][j];
                LBAR();
#pragma unroll
                for (int tt = 0; tt < 2; ++tt)
#pragma unroll
                    for (int j = 0; j < 4; ++j) OS[(63 - (mtw * 16 + q * 4 + j)) * 64 + (ntw + tt) * 16 + r] += o[tt][j];
                LBAR();
            }
        }
    }
    if (PC) {
        const LAS float* OS = (const LAS float*)SLOT(6); bf16_t* Y = (bf16_t*)(p.ws + (unsigned)opaque((int)WS_Y));
        const float lnw = p.in[opaque(28)][l * 384 + h * 64 + lane], lnb = p.in[opaque(29)][l * 384 + h * 64 + lane];
#pragma unroll
        for (int jj = 0; jj < 8; ++jj) { const int i = w * 8 + jj; const float o = OS[i * 64 + lane];
            const float mu = wave_sum(o) * (1.f / 64.f), dl = o - mu, var = wave_sum(dl * dl) * (1.f / 64.f);
            const float yv = dl * rsqrtf(var + 64e-5f) * lnw + lnb + BO[jj];
            Y[(size_t)(row0 + i) * D + 640 + h * 64 + lane] = f2bf(yv * GG[jj]); }
        LBAR();
    }
}

__device__ __forceinline__ void rw_passB(const Params& p, int unit, LAS unsigned char* lds) {
    const int tid = vopaque((int)threadIdx.x), lane = tid & 63, w = tid >> 6, r = lane & 15, q = lane >> 4;
    const int chain = unit >> 2, vs = unit & 3, dir = chain & 1, mt = w & 3; const bool act = w < 4;
    const bf16_t* Mg = (const bf16_t*)(p.ws + (unsigned)opaque((int)WS_RWM)) + (size_t)chain * NCH * 4096 + (mt * 16 + r) * 64 + q * 8;
    bf16_t* Ng = (bf16_t*)(p.ws + (unsigned)opaque((int)WS_RWN)) + (size_t)chain * NCH * 4096 + (vs * 16 + r) * 64 + mt * 16 + q * 4;
    const float* Pg = (const float*)(p.ws + (unsigned)opaque((int)WS_RWP)) + (size_t)chain * NCH * 64 + mt * 16 + q * 4;
    f32x4 hacc = {0.f, 0.f, 0.f, 0.f};
    bf16x8 Mq[6][2]; u32x2 Nq[6]; f32x4 Pq[6];
#define PB_LOAD(set, sidx) do { const int s_ = (sidx) < NCH ? (sidx) : NCH - 1; const int c_ = dir ? (s_ < 4 ? 3 - s_ : 135 - s_) : s_; \
        Mq[set][0] = *(const bf16x8*)(Mg + (size_t)c_ * 4096); Mq[set][1] = *(const bf16x8*)(Mg + (size_t)c_ * 4096 + 32); \
        Nq[set] = *(const u32x2*)(Ng + (size_t)c_ * 4096); Pq[set] = *(const f32x4*)(Pg + c_ * 64); } while (0)
    if (act) { PB_LOAD(0, 0); PB_LOAD(1, 1); PB_LOAD(2, 2); PB_LOAD(3, 3); PB_LOAD(4, 4); PB_LOAD(5, 5); }
    for (int s0 = 0; s0 < NCH; s0 += 6) {
#pragma unroll
        for (int u = 0; u < 6; ++u) { const int s = s0 + u, cs = dir ? (s < 4 ? 3 - s : 135 - s) : s;
            LAS bf16_t* HT = (LAS bf16_t*)(lds + (u & 1) * 4608);
            if (act) { const u32x2 hb = pack4h(hacc); const f32x4 hl = hacc - unpack4h(hb);
                *(u32x2*)(Ng + (size_t)cs * 4096) = hb;
                *(LAS u32x2*)(HT + r * LP + mt * 16 + q * 4) = hb; *(LAS u32x2*)(HT + 16 * LP + r * LP + mt * 16 + q * 4) = pack4h(hl); }
            asm volatile("s_waitcnt lgkmcnt(0)" ::: "memory"); __builtin_amdgcn_s_barrier(); asm volatile("" ::: "memory");
            if (act) {
                const bf16x8 B0 = *(const LAS bf16x8*)(HT + r * LP + q * 8), B1 = *(const LAS bf16x8*)(HT + r * LP + 32 + q * 8);
                const bf16x8 L0 = *(const LAS bf16x8*)(HT + 16 * LP + r * LP + q * 8), L1 = *(const LAS bf16x8*)(HT + 16 * LP + r * LP + 32 + q * 8);
                f32x4 a = Pq[u] * hacc + unpack4h(Nq[u]);
                a = __builtin_amdgcn_mfma_f32_16x16x32_f16(__builtin_bit_cast(half8_t, Mq[u][0]), __builtin_bit_cast(half8_t, L0), a, 0, 0, 0);
                a = __builtin_amdgcn_mfma_f32_16x16x32_f16(__builtin_bit_cast(half8_t, Mq[u][1]), __builtin_bit_cast(half8_t, L1), a, 0, 0, 0);
                a = __builtin_amdgcn_mfma_f32_16x16x32_f16(__builtin_bit_cast(half8_t, Mq[u][0]), __builtin_bit_cast(half8_t, B0), a, 0, 0, 0);
                a = __builtin_amdgcn_mfma_f32_16x16x32_f16(__builtin_bit_cast(half8_t, Mq[u][1]), __builtin_bit_cast(half8_t, B1), a, 0, 0, 0);
                hacc = a;
                PB_LOAD(u, s + 6);
            }
        }
    }
#undef PB_LOAD
    __syncthreads();
}

#define XB_TMO      128
#define XB_XCNT(j)  (256  + 64 * (j))
#define XB_XSUB(j)  (1280 + 64 * (j))
#define XB_XGEN(j)  (2304 + 64 * (j))
#define XB_TOP      3328
#define XB_TOPGEN   3392
#define XCD_BAR_WORDS 3456
#define XB_SPIN_CAP (1u << 18)

__device__ __forceinline__ unsigned xb_ld(unsigned* p)              { return __hip_atomic_load(p, __ATOMIC_RELAXED, __HIP_MEMORY_SCOPE_AGENT); }
__device__ __forceinline__ unsigned xb_add(unsigned* p, unsigned v) { return __hip_atomic_fetch_add(p, v, __ATOMIC_RELAXED, __HIP_MEMORY_SCOPE_AGENT); }
__device__ __forceinline__ unsigned xb_xcc_id() { return (unsigned)__builtin_amdgcn_s_getreg((3 << 11) | 20) & 0xFu; }
#define XB_SPIN(cond, bar) do { unsigned _sp = 0; while (cond) { __builtin_amdgcn_s_sleep(1); \
    if ((++_sp & 255u) == 0u) { if (xb_ld(&(bar)[XB_TMO])) break; if (_sp > XB_SPIN_CAP) { atomicAdd(&(bar)[XB_TMO], 1u); break; } } } } while (0)

struct XcdBarrier {
    unsigned* bar; unsigned x;
    volatile LAS unsigned* st;
};

__device__ __forceinline__ XcdBarrier xcd_barrier_post(unsigned* bar, volatile LAS unsigned* st) {
    XcdBarrier b; b.bar = bar; b.x = xb_xcc_id(); b.st = st;
    if (threadIdx.x == 0) (void)xb_add(&bar[XB_XCNT(b.x)], 1u);
    return b;
}
__device__ __forceinline__ void xcd_barrier_complete(unsigned* bar, unsigned x, unsigned& nloc, unsigned& nx) {
    const unsigned G = gridDim.x * gridDim.y * gridDim.z;
    unsigned sum, cnt, mine, sp = 0u;
    for (;;) {
        sum = 0u; cnt = 0u; mine = 0u;
#pragma unroll
        for (unsigned j = 0; j < 16; ++j) { const unsigned c = xb_ld(&bar[XB_XCNT(j)]); sum += c; cnt += (c > 0u) ? 1u : 0u; mine = (j == x) ? c : mine; }
        if (sum == G) break;
        __builtin_amdgcn_s_sleep(1);
        if ((++sp & 255u) == 0u) { if (xb_ld(&bar[XB_TMO])) break; if (sp > XB_SPIN_CAP) { atomicAdd(&bar[XB_TMO], 1u); break; } }
    }
    nloc = mine > 0u ? mine : 1u; nx = cnt > 0u ? cnt : 1u;
}

__device__ __forceinline__ void xcd_barrier(const XcdBarrier& b) {
    asm volatile("s_waitcnt vmcnt(0)" ::: "memory");
    __syncthreads();
    if (threadIdx.x == 0) {
        unsigned* bar = b.bar;
        __builtin_amdgcn_s_waitcnt(0);
        unsigned nloc = b.st[0], nx = b.st[1];
        if (nloc == 0u) { xcd_barrier_complete(bar, b.x, nloc, nx); b.st[0] = nloc; b.st[1] = nx; }
        const unsigned old = xb_add(&bar[XB_XSUB(b.x)], 1u);
        const unsigned gen = old / nloc;
        if (old + 1u == (gen + 1u) * nloc) {
            __builtin_amdgcn_fence(__ATOMIC_RELEASE, "agent");
            asm volatile("s_waitcnt vmcnt(0)" ::: "memory");
            const unsigned og = xb_add(&bar[XB_TOP], 1u);
            const unsigned tg = og / nx;
            if (og + 1u == (tg + 1u) * nx) xb_add(&bar[XB_TOPGEN], 1u);
            else XB_SPIN(xb_ld(&bar[XB_TOPGEN]) == tg, bar);
            __builtin_amdgcn_fence(__ATOMIC_ACQUIRE, "agent");
            xb_add(&bar[XB_XGEN(b.x)], 1u);
            asm volatile("s_waitcnt vmcnt(0)" ::: "memory");
        } else {
            XB_SPIN(xb_ld(&bar[XB_XGEN(b.x)]) == gen, bar);
            __builtin_amdgcn_fence(__ATOMIC_ACQUIRE, "agent");
            asm volatile("s_waitcnt vmcnt(0)" ::: "memory");
        }
    }
    __syncthreads();
}

__device__ __forceinline__ void ctx_gemm_items(const bf16_t* A, int lda, const bf16_t* Bt, int ldb, int nkc, float* part, LAS unsigned char* lds, int bid, int G) {
    const int tid = vopaque((int)threadIdx.x), lane = tid & 63, w = tid >> 6, r = lane & 15, q = lane >> 4;
    LAS bf16_t* As = (LAS bf16_t*)lds; LAS bf16_t* Bs = As + 64 * 264;
    const int nit = 128 * nkc;
    u32x4 ra[4], rbv[4];
#define CG_LOAD(itx) do { const int it_ = (itx) < nit ? (itx) : nit - 1; const int kc_ = it_ >> 7, rb_ = (it_ >> 4) & 7, cb_ = it_ & 15; \
        _Pragma("unroll") for (int u = 0; u < 4; ++u) { const int e = tid + u * 512, row = e >> 5, ch = e & 31; \
            ra[u] = *(const u32x4*)(A + (size_t)(rb_ * 64 + row) * lda + kc_ * 256 + ch * 8); rbv[u] = *(const u32x4*)(Bt + (size_t)(cb_ * 64 + row) * ldb + kc_ * 256 + ch * 8); } } while (0)
    if (bid < nit) CG_LOAD(bid);
    for (int it = bid; it < nit; it += G) { const int kc = it >> 7, rb = (it >> 4) & 7, cb = it & 15;
#pragma unroll
        for (int u = 0; u < 4; ++u) { const int e = tid + u * 512, row = e >> 5, ch = e & 31; *(LAS u32x4*)(As + row * 264 + ch * 8) = ra[u]; *(LAS u32x4*)(Bs + row * 264 + ch * 8) = rbv[u]; }
        LBAR();
        CG_LOAD(it + G);
        const int mt = w >> 1;
#pragma unroll
        for (int tt = 0; tt < 2; ++tt) { const int nt = (w & 1) * 2 + tt; f32x4 a = {0.f, 0.f, 0.f, 0.f}; a = mma_tile<256>(As + mt * 16 * 264, 264, Bs + nt * 16 * 264, 264, a, r, q);
#pragma unroll
            for (int j = 0; j < 4; ++j) part[((size_t)kc * MCTX + rb * 64 + mt * 16 + q * 4 + j) * D + cb * 64 + nt * 16 + r] = a[j]; }
        LBAR();
    }
#undef CG_LOAD
}

__global__ void __launch_bounds__(512, 2) fwd_kernel(Params p) {
    extern __shared__ __attribute__((aligned(16))) unsigned char lds_raw[];
    LAS unsigned char* lds = (LAS unsigned char*)lds_raw;
    cg::grid_group grid = cg::this_grid();
    const int bid = blockIdx.x, G = gridDim.x;
    volatile LAS unsigned* xst = (volatile LAS unsigned*)(lds + 163824);
    if (threadIdx.x == 0) { xst[0] = 0u; xst[1] = 0u; }
    __syncthreads();
    (void)xcd_barrier_post((unsigned*)(p.ws + (unsigned)opaque((int)WS_BAR)), xst);
#define XBAR() do { XcdBarrier xb_; xb_.bar = (unsigned*)(p.ws + (unsigned)opaque((int)WS_BAR)); xb_.x = xb_xcc_id(); xb_.st = (volatile LAS unsigned*)(lds + 163824); xcd_barrier(xb_); } while (0)

    mod_phase(p, lds, bid, G);
    __syncthreads();
    wconv_items(p, 0, 0, lds, bid, G);
    if (G == 0) grid.sync();
    XBAR();
    row_phase(p.in[opaque(0)], p.in[opaque(2)], nullptr, nullptr, nullptr, 0, nullptr, nullptr, p.in[opaque(6)], ((const float*)(p.ws + (unsigned)opaque((int)WS_MOD))), 0, 1024, ((bf16_t*)(p.ws + (unsigned)opaque((int)WS_Y))), MALL, bid, G);
    XBAR();
    for (int l = 0; l < 2; ++l) {
        const bool last = (l == 1); const int M = last ? MLAT : MALL;
        w2t_phase(p, l, bid, G);
        { pg8::Gemm g{((bf16_t*)(p.ws + (unsigned)opaque((int)WS_Y))), (const bf16_t*)((p.ws + (unsigned)opaque(0)) + WS_WIN), opaque(MALL), opaque(NU), opaque(D)}; pg8::StaticOrder S; S.init(g.M, g.N, G, bid); pg8::EpiBf16<0> E{((bf16_t*)(p.ws + (unsigned)opaque((int)WS_U))), NU, nullptr, 0, 0};
          pg8::gemm_phase<pg8::EpiBf16<0>, pg8::StaticOrder>(lds, g, S, E, nullptr); }
        XBAR();
        lr_pre_phase(p, l, bid, G);
        XBAR();
        for (int it = bid; it < 1584; it += G) rw_item<false>(p, l, it, last, lds);
        {
            unsigned* ctl = (unsigned*)(p.ws + (unsigned)opaque((int)WS_BAR)) + 3456 + l * 256 + 192;
            volatile LAS unsigned* tk = (volatile LAS unsigned*)(lds + 163832);
            for (;;) {
                if (threadIdx.x == 0) tk[0] = xb_add(ctl, 1u);
                __syncthreads();
                const unsigned t = tk[0];
                __syncthreads();
                if (t >= 2112u) break;
                la_item(p, l, (int)t, 1, last, lds);
            }
        }
        wconv_items(p, l, 1, lds, bid, G);
        XBAR();
        {
            unsigned* ctl = (unsigned*)(p.ws + (unsigned)opaque((int)WS_BAR)) + 3456 + l * 256;
            volatile LAS unsigned* tk = (volatile LAS unsigned*)(lds + 163832);
            if (bid < 96) {
                rw_passB(p, bid, lds);
                asm volatile("s_waitcnt vmcnt(0)" ::: "memory"); __syncthreads();
                if (threadIdx.x == 0) { __builtin_amdgcn_fence(__ATOMIC_RELEASE, "agent"); asm volatile("s_waitcnt vmcnt(0)" ::: "memory"); (void)xb_add(ctl + 64, 1u); }
            } else {
                la_scan(p, bid - 96, G - 96);
                asm volatile("s_waitcnt vmcnt(0)" ::: "memory"); __syncthreads();
                if (threadIdx.x == 0) {
                    __builtin_amdgcn_fence(__ATOMIC_RELEASE, "agent"); asm volatile("s_waitcnt vmcnt(0)" ::: "memory");
                    (void)xb_add(ctl + 128, 1u);
                    unsigned sp = 0; while (xb_ld(ctl + 128) < (unsigned)(G - 96)) { __builtin_amdgcn_s_sleep(1); if (++sp > (1u << 22)) break; }
                    __builtin_amdgcn_fence(__ATOMIC_ACQUIRE, "agent"); asm volatile("s_waitcnt vmcnt(0)" ::: "memory");
                }
                __syncthreads();
                for (;;) {
                    if (threadIdx.x == 0) { const bool done = xb_ld(ctl + 64) >= 96u; tk[0] = done ? 0x7fffffffu : xb_add(ctl, 1u); }
                    __syncthreads();
                    const unsigned t = tk[0];
                    __syncthreads();
                    if (t >= 2112u) break;
                    la_item(p, l, (int)t, 3, last, lds);
                }
            }
        }
        XBAR();
        for (int it = bid; it < 1584; it += G) rw_item<true>(p, l, it, last, lds);
        {
            unsigned* ctl = (unsigned*)(p.ws + (unsigned)opaque((int)WS_BAR)) + 3456 + l * 256;
            volatile LAS unsigned* tk = (volatile LAS unsigned*)(lds + 163832);
            for (;;) {
                if (threadIdx.x == 0) tk[0] = xb_add(ctl, 1u);
                __syncthreads();
                const unsigned t = tk[0];
                __syncthreads();
                if (t >= 2112u) break;
                la_item(p, l, (int)t, 3, last, lds);
            }
        }
        XBAR();
        { pg8::Gemm g{((bf16_t*)(p.ws + (unsigned)opaque((int)WS_Y))), (const bf16_t*)((p.ws + (unsigned)opaque(0)) + WS_WOUT), opaque(MLAT), opaque(D), opaque(D)}; pg8::StaticOrder S; S.init(g.M, g.N, G, bid); pg8::EpiBf16<0> E{((bf16_t*)(p.ws + (unsigned)opaque((int)WS_U))), D, nullptr, 0, 0};
          pg8::gemm_phase<pg8::EpiBf16<0>, pg8::StaticOrder>(lds, g, S, E, nullptr); }
        if (!last) ctx_gemm_items(((const bf16_t*)(p.ws + (unsigned)opaque((int)WS_Y))) + (size_t)MLAT * D, D, (const bf16_t*)((p.ws + (unsigned)opaque(0)) + WS_WOUT), D, 4, ((float*)(p.ws + (unsigned)opaque((int)WS_SRET))), lds, bid, G);
        XBAR();
        row_phase(l == 0 ? p.in[opaque(0)] : p.out, l == 0 ? p.in[opaque(2)] : ((float*)(p.ws + (unsigned)opaque((int)WS_CTX))), ((const bf16_t*)(p.ws + (unsigned)opaque((int)WS_U))), p.in[opaque(7)] + l * D, (((const float*)(p.ws + (unsigned)opaque((int)WS_MOD))) + l * 3 * 6144), 2048, p.out, ((float*)(p.ws + (unsigned)opaque((int)WS_CTX))), p.in[opaque(8)] + l * D, (((const float*)(p.ws + (unsigned)opaque((int)WS_MOD))) + l * 3 * 6144), 3072, 4096, ((bf16_t*)(p.ws + (unsigned)opaque((int)WS_Y))), M, bid, G, ((float*)(p.ws + (unsigned)opaque((int)WS_SRET))), last ? 0 : 4);
        wconv_items(p, l, 2, lds, bid, G);
        if (l == 0) wconv_items(p, 1, 0, lds, bid, G);
        XBAR();
        { pg8::Gemm g{((bf16_t*)(p.ws + (unsigned)opaque((int)WS_Y))), (const bf16_t*)((p.ws + (unsigned)opaque(0)) + WS_WGU), opaque(M), opaque(NGU), opaque(D)}; pg8::StaticOrder S; S.init(g.M, g.N, G, bid); pg8::EpiSwiGLU E{((bf16_t*)(p.ws + (unsigned)opaque((int)WS_U))), FF};
          pg8::gemm_phase<pg8::EpiSwiGLU, pg8::StaticOrder>(lds, g, S, E, nullptr); }
        XBAR();
        { pg8::Gemm g{((bf16_t*)(p.ws + (unsigned)opaque((int)WS_U))), (const bf16_t*)((p.ws + (unsigned)opaque(0)) + WS_WDN), opaque(MLAT), opaque(D), opaque(FF)}; pg8::StaticOrder S; S.init(g.M, g.N, G, bid); pg8::EpiBf16<0> E{((bf16_t*)(p.ws + (unsigned)opaque((int)WS_C2))), D, nullptr, 0, 0};
          pg8::gemm_phase<pg8::EpiBf16<0>, pg8::StaticOrder>(lds, g, S, E, nullptr); }
        if (!last) ctx_gemm_items(((const bf16_t*)(p.ws + (unsigned)opaque((int)WS_U))) + (size_t)MLAT * FF, FF, (const bf16_t*)((p.ws + (unsigned)opaque(0)) + WS_WDN), FF, 11, ((float*)(p.ws + (unsigned)opaque((int)WS_SRET))), lds, bid, G);
        XBAR();
        row_phase(p.out, ((float*)(p.ws + (unsigned)opaque((int)WS_CTX))), ((const bf16_t*)(p.ws + (unsigned)opaque((int)WS_C2))), p.in[opaque(9)] + l * D, (((const float*)(p.ws + (unsigned)opaque((int)WS_MOD))) + l * 3 * 6144), 5120, p.out, ((float*)(p.ws + (unsigned)opaque((int)WS_CTX))), last ? nullptr : p.in[opaque(6)] + (l + 1) * D, ((const float*)(p.ws + (unsigned)opaque((int)WS_MOD))) + (l + 1) * 3 * 6144, 0, 1024, last ? nullptr : ((bf16_t*)(p.ws + (unsigned)opaque((int)WS_Y))), M, bid, G, ((float*)(p.ws + (unsigned)opaque((int)WS_SRET))), last ? 0 : 11);
        if (!last) XBAR();
    }
}

extern "C" void kernel_launch(void* const* d_in, const int* in_sizes, int n_in, void* d_out, int out_size, void* d_ws, size_t ws_size, hipStream_t stream) {
    static int grid_blocks = 0;
    if (!grid_blocks) {
        int dev = 0, cus = 0, per_cu = 0;
        (void)hipGetDevice(&dev);
        (void)hipDeviceGetAttribute(&cus, hipDeviceAttributeMultiprocessorCount, dev);
        if (hipFuncSetAttribute((const void*)fwd_kernel, hipFuncAttributeMaxDynamicSharedMemorySize, LDS_BYTES) != hipSuccess) fprintf(stderr, "hipFuncSetAttribute failed\n");
        if (hipOccupancyMaxActiveBlocksPerMultiprocessor(&per_cu, (const void*)fwd_kernel, 512, LDS_BYTES) != hipSuccess || per_cu < 1) { fprintf(stderr, "occupancy query: %d\n", per_cu); per_cu = 1; }
        (void)hipGetLastError();
        grid_blocks = cus;
        if (ws_size < WS_END) fprintf(stderr, "workspace too small: %zu < %zu\n", ws_size, (size_t)WS_END);
    }
    Params p{};
    for (int i = 0; i < 34; ++i) p.in[i] = (const float*)d_in[i];
    p.out = (float*)d_out; p.ws = (unsigned char*)d_ws;
    (void)hipMemsetAsync((char*)d_ws + WS_BAR, 0, CTL_WORDS * 4, stream);
    void* args[] = {&p};
    hipError_t e = hipLaunchCooperativeKernel((const void*)fwd_kernel, dim3(grid_blocks), dim3(512), args, LDS_BYTES, stream);
    if (e != hipSuccess) fprintf(stderr, "cooperative launch failed: %s (grid %d)\n", hipGetErrorString(e), grid_blocks);
}
```

```cpp
#include <hip/hip_runtime.h>
#include <hip/hip_cooperative_groups.h>
#include <cstdio>
namespace cg = cooperative_groups;
namespace pg8 {
__device__ __forceinline__ int vopq(int v) { asm volatile("" : "+v"(v)); return v; }
#define PG8_LAS __attribute__((address_space(3)))
typedef unsigned short bf16_t;
typedef short bf16x8 __attribute__((ext_vector_type(8)));
typedef float f32x4 __attribute__((ext_vector_type(4)));
typedef unsigned u32x4 __attribute__((ext_vector_type(4)));
constexpr int BM = 256, BK = 64, HALF = 128, HTB = HALF * BK * 2  , STAGE_BYTES = 8 * HTB, NXCD = 8, WGM = 8;

__host__ __device__ __forceinline__ int lds_byte(int r, int c) { const int st = (r >> 4) * 2 + (c >> 5), rr = r & 15, cc = c & 31, ob = rr * 64 + cc * 2; return st * 1024 + (ob ^ (((ob >> 9) & 1) << 5)); }
__host__ __device__ __forceinline__ void stage_rc(int b, int& R, int& C) { const int st = b / 1024, sb = b % 1024, swz = sb ^ (((sb >> 9) & 1) << 5); R = (st >> 1) * 16 + swz / 64; C = (st & 1) * 32 + (swz % 64) / 2; }
__host__ __device__ __forceinline__ int perm32(int rho) { const int n = rho >> 4, i = rho & 15; return 8 * (i >> 2) + 4 * n + (i & 3); }

struct Unit { int pm, pn; };
struct Gemm { const bf16_t* A; const bf16_t* Bt; int M, N, K; };

struct StaticOrder {
    int nM, nN, nwg, G, c;
    __host__ __device__ void init(int M, int N, int G_, int c_) { nM = M / BM; nN = N / BM; nwg = nM * nN; G = G_; c = c_; }
    __host__ __device__ bool next(int i, Unit& u) const {
        const long L = (long)i * G + c; if (L >= nwg) return false;
        int wgid = (int)L; { const int q = nwg / NXCD, r = nwg % NXCD, xcd = wgid % NXCD, off = wgid / NXCD; wgid = (xcd < r ? xcd * (q + 1) : r * (q + 1) + (xcd - r) * q) + off; }
        const int nig = WGM * nN, gid = wgid / nig, fm = gid * WGM, gsz = (nM - fm) < WGM ? (nM - fm) : WGM;
        u.pm = fm + ((wgid % nig) % gsz); u.pn = (wgid % nig) / gsz; return true;
    }
    __device__ __forceinline__ void a_ready(const Unit&) const {}
    __device__ __forceinline__ void done(const Unit&) const {}
};
__device__ __forceinline__ unsigned cvt_pk_bf16(float lo, float hi) { unsigned r; asm volatile("v_cvt_pk_bf16_f32 %0, %1, %2" : "=v"(r) : "v"(lo), "v"(hi)); return r; }
typedef float f32x2 __attribute__((ext_vector_type(2)));
__device__ __forceinline__ f32x2 gelu_pk(f32x2 v) {
    const f32x2 av = __builtin_elementwise_abs(v), d = av * 0.2316418882f + 1.0f;
    f32x2 t; t.x = __builtin_amdgcn_rcpf(d.x); t.y = __builtin_amdgcn_rcpf(d.y);
    f32x2 q = t * 0.5307027145f + (-0.7265760135f); q = q * t + 0.7107068705f; q = q * t + (-0.142248368f); q = q * t + 0.127414796f; q = q * t;
    const f32x2 s = (v * v) * (-0.72134752044f);
    f32x2 e; e.x = __builtin_amdgcn_exp2f(s.x); e.y = __builtin_amdgcn_exp2f(s.y);
    const f32x2 m = v * (q * e), r = v - m;
    f32x2 o; o.x = v.x < 0.f ? m.x : r.x; o.y = v.y < 0.f ? m.y : r.y; return o;
}

struct EpiF32 {
    static constexpr bool PERM = false, AFTER_DRAIN = false;
    float* C; int ldc; const float* bias;
    __device__ __forceinline__ void operator()(const f32x4 (&acc)[2][2][4][2], const Unit& u, int wr, int wc, int fr, int fq) const {
        const int row0 = u.pm * BM + wr * 64 + fr, col0 = u.pn * BM + wc * 32 + 4 * fq;
        f32x4 bv[2][2];
#pragma unroll
        for (int bj = 0; bj < 2; ++bj)
#pragma unroll
            for (int n = 0; n < 2; ++n) bv[bj][n] = bias ? *(const f32x4*)(bias + col0 + bj * HALF + n * 16) : (f32x4){0.f, 0.f, 0.f, 0.f};
#pragma unroll
        for (int ai = 0; ai < 2; ++ai)
#pragma unroll
            for (int m = 0; m < 4; ++m) { float* rowp = C + (size_t)(row0 + ai * HALF + m * 16) * ldc + col0;
#pragma unroll
                for (int bj = 0; bj < 2; ++bj)
#pragma unroll
                    for (int n = 0; n < 2; ++n) *(f32x4*)(rowp + bj * HALF + n * 16) = acc[ai][bj][m][n] + bv[bj][n]; }
    }
};
template <int ACT  > struct EpiBf16 {
    static constexpr bool PERM = true, AFTER_DRAIN = false;
    bf16_t* O; int ldc; const float* bias; int split_cols; size_t split_stride;
    __device__ __forceinline__ void operator()(const f32x4 (&acc)[2][2][4][2], const Unit& u, int wr, int wc, int fr, int fq) const {
        const int row0 = u.pm * BM + wr * 64 + fr; int colt = u.pn * BM; bf16_t* base = O;
        if (split_cols) { const int t = colt / split_cols; base += (size_t)t * split_stride; colt -= t * split_cols; }
        const int col0 = colt + wc * 32 + 8 * fq, bcol0 = u.pn * BM + wc * 32 + 8 * fq;
        f32x4 bv[2][2];
#pragma unroll
        for (int bj = 0; bj < 2; ++bj)
#pragma unroll
            for (int n = 0; n < 2; ++n) bv[bj][n] = bias ? *(const f32x4*)(bias + bcol0 + bj * HALF + 4 * n) : (f32x4){0.f, 0.f, 0.f, 0.f};
#pragma unroll
        for (int ai = 0; ai < 2; ++ai)
#pragma unroll
            for (int m = 0; m < 4; ++m) { bf16_t* rowp = base + (size_t)(row0 + ai * HALF + m * 16) * ldc + col0;
#pragma unroll
                for (int bj = 0; bj < 2; ++bj) { f32x4 v0 = acc[ai][bj][m][0] + bv[bj][0], v1 = acc[ai][bj][m][1] + bv[bj][1];
                    if (ACT == 1) { f32x2 a = gelu_pk((f32x2){v0[0], v0[1]}), b = gelu_pk((f32x2){v0[2], v0[3]}), c = gelu_pk((f32x2){v1[0], v1[1]}), d = gelu_pk((f32x2){v1[2], v1[3]});
                        v0 = (f32x4){a.x, a.y, b.x, b.y}; v1 = (f32x4){c.x, c.y, d.x, d.y}; }
                    if (ACT == 2) {
#pragma unroll
                        for (int j = 0; j < 4; ++j) { v0[j] = 0.5f * v0[j] * (1.0f + erff(v0[j] * 0.70710678f)); v1[j] = 0.5f * v1[j] * (1.0f + erff(v1[j] * 0.70710678f)); } }
                    u32x4 w; w.x = cvt_pk_bf16(v0[0], v0[1]); w.y = cvt_pk_bf16(v0[2], v0[3]); w.z = cvt_pk_bf16(v1[0], v1[1]); w.w = cvt_pk_bf16(v1[2], v1[3]);
                    *(u32x4*)(rowp + bj * HALF) = w; } }
    }
};
template <class Epi, class Sched, bool STAMP = false>
__device__ __forceinline__ void gemm_phase(PG8_LAS unsigned char* lds, const Gemm g, const Sched& S, const Epi& E, unsigned long long* stamps) {
    const int tid = vopq((int)threadIdx.x), wid = __builtin_amdgcn_readfirstlane(tid >> 6), lane = tid & 63, wr = wid >> 2, wc = wid & 3, fr = lane & 15, fq = lane >> 4;
    const int K = g.K, nt = K / BK;
    int ts_lo = 0, ts_hi = 0, nts = 0; const unsigned long long rt_entry = STAMP ? (unsigned long long)wall_clock64() : 0ull;
#define PG8_STAMP() do { if (STAMP && wid == 0 && nts < 64) { const unsigned long long _c = (unsigned long long)clock64(); \
        ts_lo = (lane == nts) ? (int)(unsigned)_c : ts_lo; ts_hi = (lane == nts) ? (int)(unsigned)(_c >> 32) : ts_hi; ++nts; } } while (0)
    PG8_STAMP();
    unsigned voffA[2], voffB[2];
#pragma unroll
    for (int i = 0; i < 2; ++i) { int R, C; stage_rc(tid * 16 + i * 8192, R, C); const int Rb = Epi::PERM ? ((R & ~31) + perm32(R & 31)) : R;
        voffA[i] = (unsigned)(R * K + C) * 2u; voffB[i] = (unsigned)(Rb * K + C) * 2u; }
    const size_t kstep = (size_t)(BK * 2);
    const size_t hstep = (size_t)HALF * K * 2;
    const size_t tstep = 2 * hstep;
    const unsigned ldsw = (unsigned)wid * 1024u;
    const int aoff = lds_byte(wr * 64 + fr, fq * 8), boff = lds_byte(wc * 32 + fr, fq * 8);
#define PG8_SA(b, h) (((b) * 2 + (h)) * HTB)
#define PG8_SB(b, h) ((4 + (b) * 2 + (h)) * HTB)
#define PG8_STAGE(bufoff, gbase, voff) do { _Pragma("unroll") for (int _i = 0; _i < 2; ++_i) \
        __builtin_amdgcn_global_load_lds((const unsigned*)((const char*)(gbase) + (voff)[_i]), (PG8_LAS unsigned*)(lds + (bufoff) + ldsw + _i * 8192), 16, 0, 0); } while (0)
#define PG8_LDA(dst, b, h) do { _Pragma("unroll") for (int m = 0; m < 4; ++m) _Pragma("unroll") for (int k = 0; k < 2; ++k) dst[m][k] = *(const PG8_LAS bf16x8*)(lds + PG8_SA(b, h) + aoff + m * 2048 + k * 1024); } while (0)
#define PG8_LDB(dst, b, h) do { _Pragma("unroll") for (int n = 0; n < 2; ++n) _Pragma("unroll") for (int k = 0; k < 2; ++k) dst[n][k] = *(const PG8_LAS bf16x8*)(lds + PG8_SB(b, h) + boff + n * 2048 + k * 1024); } while (0)
#define PG8_MMA(ai, bj, At, Bt) do { __builtin_amdgcn_s_setprio(1); _Pragma("unroll") for (int m = 0; m < 4; ++m) _Pragma("unroll") for (int n = 0; n < 2; ++n) _Pragma("unroll") for (int k = 0; k < 2; ++k) \
        acc[ai][bj][m][n] = __builtin_amdgcn_mfma_f32_16x16x32_bf16(Bt[n][k], At[m][k], acc[ai][bj][m][n], 0, 0, 0); __builtin_amdgcn_s_setprio(0); } while (0)
#define PG8_WAIT_V(n) asm volatile("s_waitcnt vmcnt(" #n ")" ::: "memory")
#define PG8_WAIT_L(n) asm volatile("s_waitcnt lgkmcnt(" #n ")" ::: "memory")
#define PG8_BAR __builtin_amdgcn_s_barrier()
#define PG8_SCHED __builtin_amdgcn_sched_barrier(0)
    Unit cur, nxt; int ui = 0;
    if (!S.next(0, cur)) return;
    f32x4 acc[2][2][4][2];
#pragma unroll
    for (int a = 0; a < 2; ++a)
#pragma unroll
        for (int b = 0; b < 2; ++b)
#pragma unroll
            for (int m = 0; m < 4; ++m)
#pragma unroll
                for (int n = 0; n < 2; ++n) acc[a][b][m][n] = (f32x4){0.f, 0.f, 0.f, 0.f};
    bf16x8 At[4][2], B0[2][2], B1[2][2];
    const char* cA = (const char*)g.A + (size_t)cur.pm * tstep; const char* cB = (const char*)g.Bt + (size_t)cur.pn * tstep;
    S.a_ready(cur);
    PG8_STAGE(PG8_SB(0, 0), cB, voffB); PG8_STAGE(PG8_SA(0, 0), cA, voffA); PG8_STAGE(PG8_SB(0, 1), cB + hstep, voffB); PG8_STAGE(PG8_SA(0, 1), cA + hstep, voffA);
    if (wr == 1) PG8_BAR;
    PG8_WAIT_V(4); PG8_BAR;
    PG8_STAGE(PG8_SB(1, 0), cB + kstep, voffB); PG8_STAGE(PG8_SA(1, 0), cA + kstep, voffA); PG8_STAGE(PG8_SB(1, 1), cB + hstep + kstep, voffB);
    PG8_WAIT_V(6); PG8_BAR;
    PG8_STAMP();
    for (;;) {
        const bool has_next = S.next(ui + 1, nxt);
        const char* nA = has_next ? (const char*)g.A + (size_t)nxt.pm * tstep : cA; const char* nB = has_next ? (const char*)g.Bt + (size_t)nxt.pn * tstep : cB;
        for (int t = 0; t < nt; t += 2) {
            const bool last = (t == nt - 2);
            const char* a1 = cA + (size_t)(t + 1) * kstep;
            const char* a2 = last ? nA : cA + (size_t)(t + 2) * kstep; const char* b2 = last ? nB : cB + (size_t)(t + 2) * kstep;
            const char* a3 = a2 + kstep; const char* b3 = b2 + kstep;
            if (last && has_next) S.a_ready(nxt);
            PG8_LDB(B0, 0, 0); PG8_SCHED; PG8_LDA(At, 0, 0); PG8_STAGE(PG8_SA(1, 1), a1 + hstep, voffA);
            PG8_WAIT_L(8); PG8_BAR; PG8_WAIT_L(0); PG8_MMA(0, 0, At, B0); PG8_BAR; PG8_SCHED;
            PG8_LDB(B1, 0, 1); PG8_STAGE(PG8_SB(0, 0), b2, voffB);
            PG8_BAR; PG8_WAIT_L(0); PG8_MMA(0, 1, At, B1); PG8_BAR;
            PG8_LDA(At, 0, 1); PG8_STAGE(PG8_SA(0, 0), a2, voffA);
            PG8_BAR; PG8_WAIT_L(0); PG8_MMA(1, 0, At, B0); PG8_BAR; PG8_SCHED;
            PG8_STAGE(PG8_SB(0, 1), b2 + hstep, voffB);
            PG8_WAIT_V(6); PG8_BAR; PG8_MMA(1, 1, At, B1); PG8_BAR;
            PG8_LDB(B0, 1, 0); PG8_SCHED; PG8_LDA(At, 1, 0); PG8_STAGE(PG8_SA(0, 1), a2 + hstep, voffA);
            PG8_WAIT_L(8); PG8_BAR; PG8_WAIT_L(0); PG8_MMA(0, 0, At, B0); PG8_BAR; PG8_SCHED;
            PG8_LDB(B1, 1, 1); PG8_STAGE(PG8_SB(1, 0), b3, voffB);
            PG8_BAR; PG8_WAIT_L(0); PG8_MMA(0, 1, At, B1); PG8_BAR;
            PG8_LDA(At, 1, 1); PG8_STAGE(PG8_SA(1, 0), a3, voffA);
            PG8_BAR; PG8_WAIT_L(0); PG8_MMA(1, 0, At, B0); PG8_BAR; PG8_SCHED;
            PG8_STAGE(PG8_SB(1, 1), b3 + hstep, voffB);
            PG8_WAIT_V(6); PG8_BAR; PG8_MMA(1, 1, At, B1); PG8_BAR;
        }
        PG8_STAMP();
        if constexpr (!Epi::AFTER_DRAIN) { E(acc, cur, wr, wc, fr, fq); S.done(cur); }
        PG8_STAMP();
        if (!has_next) break;
#pragma unroll
        for (int a = 0; a < 2; ++a)
#pragma unroll
            for (int b = 0; b < 2; ++b)
#pragma unroll
                for (int m = 0; m < 4; ++m)
#pragma unroll
                    for (int n = 0; n < 2; ++n) acc[a][b][m][n] = (f32x4){0.f, 0.f, 0.f, 0.f};
        cur = nxt; cA = nA; cB = nB; ++ui;
    }
    PG8_WAIT_V(0);
    if (wr == 0) PG8_BAR;
    PG8_BAR;
    if constexpr (Epi::AFTER_DRAIN) { E.fused(acc, cur, wr, wc, fr, fq, lds, wid, lane); S.done(cur); }
    PG8_STAMP();
    if (STAMP && wid == 0) { stamps[lane] = lane < nts ? (((unsigned long long)(unsigned)ts_hi << 32) | (unsigned)ts_lo) : 0ull;
        if (lane == 62) stamps[62] = rt_entry; if (lane == 63) stamps[63] = (unsigned long long)wall_clock64(); }
#undef PG8_STAMP
#undef PG8_SA
#undef PG8_SB
#undef PG8_STAGE
#undef PG8_LDA
#undef PG8_LDB
#undef PG8_MMA
#undef PG8_WAIT_V
#undef PG8_WAIT_L
#undef PG8_BAR
#undef PG8_SCHED
}
}
namespace pg8 {
struct EpiSwiGLU {
    static constexpr bool PERM = true, AFTER_DRAIN = false;
    bf16_t* H; int ldh;
    __device__ __forceinline__ void operator()(const f32x4 (&acc)[2][2][4][2], const Unit& u, int wr, int wc, int fr, int fq) const {
        const int row0 = u.pm * BM + wr * 64 + fr, col0 = u.pn * HALF + wc * 32 + 8 * fq;
#pragma unroll
        for (int ai = 0; ai < 2; ++ai)
#pragma unroll
            for (int m = 0; m < 4; ++m) { bf16_t* rowp = H + (size_t)(row0 + ai * HALF + m * 16) * ldh + col0;
                float hv[8];
#pragma unroll
                for (int n = 0; n < 2; ++n)
#pragma unroll
                    for (int j = 0; j < 4; ++j) { const float g = acc[ai][0][m][n][j], up = acc[ai][1][m][n][j]; hv[n * 4 + j] = g * up * __builtin_amdgcn_rcpf(1.0f + __expf(-g)); }
                u32x4 w; w.x = cvt_pk_bf16(hv[0], hv[1]); w.y = cvt_pk_bf16(hv[2], hv[3]); w.z = cvt_pk_bf16(hv[4], hv[5]); w.w = cvt_pk_bf16(hv[6], hv[7]);
                *(u32x4*)rowp = w; }
    }
};
}

#define LAS __attribute__((address_space(3)))
typedef unsigned short bf16_t;
typedef short bf16x8 __attribute__((ext_vector_type(8)));
typedef float f32x4 __attribute__((ext_vector_type(4)));
typedef unsigned u32x4 __attribute__((ext_vector_type(4)));
typedef unsigned u32x2 __attribute__((ext_vector_type(2)));

constexpr int D = 1024, MLAT = 16384, MCTX = 512, MALL = 16896, SEQ = 8192, CTXL = 256, NCH = 132;
constexpr int INW = 3680, NU = 3840, FF = 2816, NGU = 5632;
constexpr size_t WS_MOD = 0;
constexpr size_t WS_CTX = 147456;
constexpr size_t WS_WA = WS_CTX + (size_t)MCTX * D * 4;
constexpr size_t WA_BYTES = (size_t)3168 * 8192;
constexpr size_t WS_WGU = WS_WA;
constexpr size_t WS_WDN = WS_WGU + (size_t)NGU * D * 2;
constexpr size_t WS_WIN = WS_WDN + (size_t)D * FF * 2;
constexpr size_t WS_RWN = WS_WA;
static_assert(WS_WIN + (size_t)NU * D * 2 <= WS_WA + WA_BYTES, "region A");
constexpr size_t WS_WOUT = WS_WA + WA_BYTES;
constexpr size_t WS_U = WS_WOUT + (size_t)D * D * 2;
constexpr size_t U_BYTES = (size_t)MALL * NU * 2;
constexpr size_t H_BYTES = (size_t)MALL * FF * 2;
constexpr size_t C_BYTES = (size_t)MALL * D * 4;
constexpr size_t WS_C2 = WS_U + H_BYTES;
constexpr size_t WS_RWM = WS_U + U_BYTES;
constexpr size_t WS_RWP = WS_RWM + (size_t)3168 * 8192;
constexpr size_t WS_W2T = WS_RWP + (size_t)3168 * 256;
constexpr size_t WS_ACT = WS_W2T + (size_t)6 * 20480 * 2;
constexpr size_t WS_Y = WS_C2 + C_BYTES;
constexpr size_t WS_SRET = WS_Y + (size_t)MALL * D * 2;
constexpr size_t WS_SGLA = WS_SRET + (size_t)16 * NCH * 4096 * 2;
constexpr size_t WS_DEC = WS_SGLA + (size_t)16 * NCH * 4608 * 2;
constexpr size_t WS_END = WS_DEC + (size_t)32 * NCH * 64 * 4;
static_assert(WS_ACT + (size_t)MALL * 192 * 2 <= WS_Y, "tail overlaps y");
constexpr size_t WS_BAR = WS_END;
constexpr int CTL_WORDS = 3456 + 512;
static_assert(WS_BAR + CTL_WORDS * 4 <= (size_t)268435456, "workspace too large");
constexpr int LDS_BYTES = 163840;
#ifndef PHM
#define PHM 0xFFFF
#endif

struct Params { const float* in[34]; float* out; unsigned char* ws; };

__device__ __forceinline__ int opaque(int v) { asm volatile("" : "+s"(v)); return v; }
__device__ __forceinline__ int vopaque(int v) { asm volatile("" : "+v"(v)); return v; }
typedef __bf16 bf16v2_t __attribute__((ext_vector_type(2)));
typedef float f32x2_t __attribute__((ext_vector_type(2)));
__device__ __forceinline__ unsigned pk2(float lo, float hi) { const f32x2_t v = {lo, hi}; const bf16v2_t b = __builtin_convertvector(v, bf16v2_t); return __builtin_bit_cast(unsigned, b); }
__device__ __forceinline__ bf16_t f2bf(float f) { return (bf16_t)(pk2(f, 0.f) & 0xffffu); }
__device__ __forceinline__ float bf2f(bf16_t b) { return __uint_as_float(((unsigned)b) << 16); }
template <int CTRL, int RMASK> __device__ __forceinline__ float dpp_(float v) { return __builtin_bit_cast(float, __builtin_amdgcn_update_dpp(0, __builtin_bit_cast(int, v), CTRL, RMASK, 0xf, false)); }
__device__ __forceinline__ float row16_sum(float v) {
    v += dpp_<0xb1, 0xf>(v); v += dpp_<0x4e, 0xf>(v); v += dpp_<0x124, 0xf>(v); v += dpp_<0x128, 0xf>(v); return v; }
__device__ __forceinline__ float wave_sum(float v) {
    v = row16_sum(v); v += dpp_<0x142, 0xa>(v); v += dpp_<0x143, 0xc>(v);
    return __builtin_bit_cast(float, __builtin_amdgcn_readlane(__builtin_bit_cast(int, v), 63)); }
__device__ __forceinline__ float sigmoidf_(float x) { return 1.f / (1.f + __expf(-x)); }
__device__ __forceinline__ float siluf_(float x) { return x / (1.f + __expf(-x)); }
__device__ __forceinline__ int chunk_row0(int b, int cs) { return cs < 4 ? MLAT + b * CTXL + cs * 64 : b * SEQ + (cs - 4) * 64; }

template <int K> __device__ __forceinline__ f32x4 mma_tile(const LAS bf16_t* A, int lda, const LAS bf16_t* Bt, int ldb, f32x4 acc, int r, int q) {
#pragma unroll
    for (int k0 = 0; k0 < K; k0 += 32) {
        const bf16x8 a = *(const LAS bf16x8*)(A + r * lda + k0 + q * 8);
        const bf16x8 b = *(const LAS bf16x8*)(Bt + r * ldb + k0 + q * 8);
        acc = __builtin_amdgcn_mfma_f32_16x16x32_bf16(a, b, acc, 0, 0, 0);
    }
    return acc;
}

__device__ __forceinline__ void mod_phase(const Params& p, LAS unsigned char* lds, int bid, int nb) {
    LAS float* sc = (LAS float*)lds;
    LAS float* red = sc + 3072;
    const int tid = vopaque((int)threadIdx.x);
    for (int i = tid; i < 3072; i += 512) { const int s = i >> 10, k = i & 1023; const float v = s < 2 ? p.in[opaque(1)][s * 1024 + k] : p.in[opaque(3)][k]; sc[i] = siluf_(v); }
    __syncthreads();
    const int col = tid & 63, kg = tid >> 6;
    float* modo = (float*)(p.ws + (unsigned)opaque((int)WS_MOD));
    for (int it = bid; it < 192; it += nb) {
        const int l = it / 96, c0 = (it % 96) * 64;
        const float* W = p.in[opaque(4)] + (size_t)l * D * 6144 + c0 + col;
        float a0 = 0.f, a1 = 0.f, a2 = 0.f;
#pragma unroll 32
        for (int k = kg * 128; k < kg * 128 + 128; ++k) { const float w = W[(size_t)k * 6144]; a0 += sc[k] * w; a1 += sc[1024 + k] * w; a2 += sc[2048 + k] * w; }
        red[(kg * 3 + 0) * 64 + col] = a0; red[(kg * 3 + 1) * 64 + col] = a1; red[(kg * 3 + 2) * 64 + col] = a2;
        __syncthreads();
        if (tid < 192) { const int s = tid >> 6; float t = 0.f;
#pragma unroll
            for (int g = 0; g < 8; ++g) t += red[(g * 3 + s) * 64 + col];
            modo[(l * 3 + s) * 6144 + c0 + col] = t + p.in[opaque(5)][l * 6144 + c0 + col]; }
        __syncthreads();
    }
}

__device__ __forceinline__ void wt_item(const float* src, int ldw, bool zero, bf16_t* dst, int K, LAS float* scr, int lane) {
    float tv[32];
#pragma unroll
    for (int i = 0; i < 32; ++i) { const int kk = 2 * i + (lane >> 5); tv[i] = zero ? 0.f : src[(size_t)kk * ldw + (lane & 31)]; }
#pragma unroll
    for (int i = 0; i < 32; ++i) { const int kk = 2 * i + (lane >> 5); scr[kk * 33 + (lane & 31)] = tv[i]; }
    asm volatile("s_waitcnt lgkmcnt(0)" ::: "memory");
    const int c = lane & 7;
#pragma unroll
    for (int j = 0; j < 4; ++j) { const int n = (lane >> 3) + 8 * j; const LAS float* s = scr + (8 * c) * 33 + n;
        u32x4 o; o.x = pk2(s[0], s[33]); o.y = pk2(s[66], s[99]); o.z = pk2(s[132], s[165]); o.w = pk2(s[198], s[231]);
        *(u32x4*)(dst + (size_t)n * K + 8 * c) = o; }
    asm volatile("s_waitcnt lgkmcnt(0)" ::: "memory");
}
__device__ __forceinline__ void wconv_items(const Params& p, int l, int set, LAS unsigned char* lds, int bid, int G) {
    unsigned char* ws = p.ws; const int tid = vopaque((int)threadIdx.x), lane = tid & 63, wv = tid >> 6, gw = bid * 8 + wv, ngw = G * 8; LAS float* scr = (LAS float*)(lds + wv * 8448);
    if (set == 0) {
        const float* W = p.in[opaque(10)] + (size_t)l * D * INW;
        for (int it = gw; it < 120 * 16; it += ngw) { const int kb = it / 120, nb = it % 120;
            wt_item(W + (size_t)(kb * 64) * INW + nb * 32, INW, nb * 32 >= INW, (bf16_t*)(ws + WS_WIN) + (size_t)(nb * 32) * D + kb * 64, D, scr, lane); }
    } else {
        for (int it = gw + (set == 2 ? 512 : 0); it < (set == 2 ? 512 + 2816 + 1408 : 512); it += ngw) {
            int r = it;
            if (r < 512) { const int kb = r / 32, nb = r % 32;
                wt_item(p.in[opaque(30)] + (size_t)l * D * D + (size_t)(kb * 64) * D + nb * 32, D, false, (bf16_t*)(ws + WS_WOUT) + (size_t)(nb * 32) * D + kb * 64, D, scr, lane); continue; }
            r -= 512;
            if (r < 2816) { const int kb = r / 176, nb = r % 176; const int n0 = nb * 32, tile = n0 >> 8, within = n0 & 255, hid = tile * 128 + (within & 127);
                const float* W = (within < 128 ? p.in[opaque(31)] : p.in[opaque(32)]) + (size_t)l * D * FF;
                wt_item(W + (size_t)(kb * 64) * FF + hid, FF, false, (bf16_t*)(ws + WS_WGU) + (size_t)n0 * D + kb * 64, D, scr, lane); continue; }
            r -= 2816;
            { const int kb = r / 32, nb = r % 32;
                wt_item(p.in[opaque(33)] + (size_t)l * FF * D + (size_t)(kb * 64) * D + nb * 32, D, false, (bf16_t*)(ws + WS_WDN) + (size_t)(nb * 32) * FF + kb * 64, FF, scr, lane); }
        }
    }
}

__device__ __forceinline__ void row_phase(const float* res_lat, const float* res_ctx, const bf16_t* Cm, const float* gpost, const float* modg, int gate_off,
                                          float* dst_lat, float* dst_ctx, const float* gpre, const float* modn, int sh_off, int sc_off, bf16_t* xn, int M, int bid, int G, const float* part = nullptr, int npart = 0) {
    const int tid = vopaque((int)threadIdx.x), lane = tid & 63, gw = bid * 8 + (tid >> 6), ngw = G * 8;
    f32x4 nv[4], nc[4];
#define RP_LOAD(mm) do { const int m_ = (mm); const float* rr_ = m_ >= MLAT ? res_ctx + (size_t)(m_ - MLAT) * D : res_lat + (size_t)m_ * D; \
        _Pragma("unroll") for (int j = 0; j < 4; ++j) { nv[j] = *(const f32x4*)(rr_ + j * 256 + lane * 4); \
            if (Cm) { if (npart > 0 && m_ >= MLAT) { f32x4 t_ = {0.f, 0.f, 0.f, 0.f}; for (int k_ = 0; k_ < npart; ++k_) t_ = t_ + *(const f32x4*)(part + ((size_t)k_ * MCTX + (m_ - MLAT)) * D + j * 256 + lane * 4); nc[j] = t_; } \
                      else { const u32x2 c_ = *(const u32x2*)(Cm + (size_t)m_ * D + j * 256 + lane * 4); nc[j] = (f32x4){__uint_as_float(c_.x << 16), __uint_as_float(c_.x & 0xffff0000u), __uint_as_float(c_.y << 16), __uint_as_float(c_.y & 0xffff0000u)}; } } } } while (0)
    if (gw < M) RP_LOAD(gw);
    for (int m = gw; m < M; m += ngw) {
        const bool isctx = m >= MLAT; const int ms = isctx ? 2 : (m >> 13);
        f32x4 v[4], c[4];
#pragma unroll
        for (int j = 0; j < 4; ++j) { v[j] = nv[j]; c[j] = nc[j]; }
        if (m + ngw < M) RP_LOAD(m + ngw);
        if (Cm) {
            f32x4 gp[4], gt[4]; float ss = 0.f;
#pragma unroll
            for (int j = 0; j < 4; ++j) { const int col = j * 256 + lane * 4; gp[j] = *(const f32x4*)(gpost + col); gt[j] = *(const f32x4*)(modg + ms * 6144 + gate_off + col);
                ss += c[j][0] * c[j][0] + c[j][1] * c[j][1] + c[j][2] * c[j][2] + c[j][3] * c[j][3]; }
            ss = wave_sum(ss); const float rstd = rsqrtf(ss * (1.f / 1024.f) + 1e-6f);
#pragma unroll
            for (int j = 0; j < 4; ++j) v[j] = v[j] + gt[j] * (c[j] * rstd * gp[j]);
        }
        if (dst_lat) { float* drow = isctx ? dst_ctx + (size_t)(m - MLAT) * D : dst_lat + (size_t)m * D;
#pragma unroll
            for (int j = 0; j < 4; ++j) *(f32x4*)(drow + j * 256 + lane * 4) = v[j]; }
        if (xn) {
            f32x4 gp[4], sh[4], sc[4]; float ss = 0.f;
#pragma unroll
            for (int j = 0; j < 4; ++j) { const int col = j * 256 + lane * 4; gp[j] = *(const f32x4*)(gpre + col); sh[j] = *(const f32x4*)(modn + ms * 6144 + sh_off + col); sc[j] = *(const f32x4*)(modn + ms * 6144 + sc_off + col);
                ss += v[j][0] * v[j][0] + v[j][1] * v[j][1] + v[j][2] * v[j][2] + v[j][3] * v[j][3]; }
            ss = wave_sum(ss); const float rstd = rsqrtf(ss * (1.f / 1024.f) + 1e-6f);
#pragma unroll
            for (int j = 0; j < 4; ++j) { const int col = j * 256 + lane * 4; const f32x4 y = (v[j] * rstd * gp[j]) * (sc[j] + 1.f) + sh[j];
                u32x2 o; o.x = pk2(y[0], y[1]); o.y = pk2(y[2], y[3]); *(u32x2*)(xn + (size_t)m * D + col) = o; }
        }
    }
#undef RP_LOAD
}

constexpr int LP = 72;
#define LBAR() do { asm volatile("s_waitcnt lgkmcnt(0)" ::: "memory"); __builtin_amdgcn_s_barrier(); asm volatile("" ::: "memory"); } while (0)
__device__ __forceinline__ float logsig_(float z) { return fminf(z, 0.f) - __logf(1.f + __expf(-fabsf(z))); }
__device__ __forceinline__ void la_item(const Params& p, int l, int idx, int pass, bool last, LAS unsigned char* lds) {
    const int tid = vopaque((int)threadIdx.x), lane = tid & 63, w = tid >> 6, r = lane & 15, q = lane >> 4;
    const int kind = idx / 1056, rem = idx % 1056, b = rem / 528, rem2 = rem % 528, cs = rem2 >> 2, h = rem2 & 3;
    if (pass == 3 && last && cs < 4) return;
    const int DK = kind ? 48 : 64, DV = kind ? 96 : 64;
    const int qoff = kind ? 1024 + 48 * h : 64 * h, koff = kind ? 1216 + 48 * h : 256 + 64 * h, voff = kind ? 1408 + 96 * h : 512 + 64 * h, goff = kind ? 1792 + 96 * h : 768 + 64 * h;
    const int ycol = kind ? 256 + 96 * h : 64 * h;
    const int row0 = chunk_row0(b, cs);
    const int chain = ((kind * 2 + b) * 4 + h) * 2;
    const bf16_t* U = (const bf16_t*)(p.ws + (unsigned)opaque((int)WS_U));
    bf16_t* Y = (bf16_t*)(p.ws + (unsigned)opaque((int)WS_Y));
    bf16_t* Sf = kind ? (bf16_t*)(p.ws + (unsigned)opaque((int)WS_SGLA)) + ((size_t)(chain - 16) * NCH + cs) * 4608 : (bf16_t*)(p.ws + (unsigned)opaque((int)WS_SRET)) + ((size_t)chain * NCH + cs) * 4096;
    bf16_t* Sb = Sf + (size_t)NCH * (kind ? 4608 : 4096);
    float* dec = (float*)(p.ws + (unsigned)opaque((int)WS_DEC)) + ((size_t)chain * NCH + cs) * 64;
    LAS float* cumf = (LAS float*)lds; LAS float* cumb = cumf + 4096;
    LAS bf16_t* QF = (LAS bf16_t*)(lds + 32768); LAS bf16_t* QB = QF + 64 * LP; LAS bf16_t* KF = QB + 64 * LP; LAS bf16_t* KB = KF + 64 * LP;
    LAS bf16_t* VT = KB + 64 * LP; LAS bf16_t* PF = VT + 96 * LP; LAS bf16_t* PB = PF + 64 * LP; LAS bf16_t* STF = PB + 64 * LP; LAS bf16_t* STB = STF + 96 * LP;
    LAS float* red = (LAS float*)(STB + 96 * LP);
    if (kind == 0) {
        const float lgf = logf(1.f - exp2f(-5.f - (float)h)), lgb = logf(1.f - exp2f(-5.f - (float)(3 - h)));
        for (int e = tid; e < 4096; e += 512) { const int i = e >> 6; cumf[e] = (float)(i + 1) * lgf; cumb[e] = (float)(64 - i) * lgb; }
    } else {
        const float* wa2f = p.in[opaque(12)] + l * 16 * 192 + h * 48; const float* baf = p.in[opaque(13)] + l * 192 + h * 48;
        const float* wa2b = p.in[opaque(14)] + l * 16 * 192 + h * 48; const float* bab = p.in[opaque(15)] + l * 192 + h * 48;
        LAS bf16_t* LR = (LAS bf16_t*)(lds + 32768); LAS bf16_t* WtF = LR + 64 * 40; LAS bf16_t* WtB = WtF + 48 * 40; LAS float* SEG = (LAS float*)(WtB + 48 * 40);
        if (tid < 256) { const int i = tid >> 2, ch = tid & 3; *(LAS u32x4*)(LR + i * 40 + ch * 8) = *(const u32x4*)(U + (size_t)(row0 + i) * NU + 2176 + ch * 8); }
        for (int e = tid; e < 48 * 32; e += 512) { const int d = e % 48, k = e / 48; WtF[d * 40 + k] = k < 16 ? f2bf(wa2f[k * 192 + d]) : (bf16_t)0; WtB[d * 40 + k] = k >= 16 ? f2bf(wa2b[(k - 16) * 192 + d]) : (bf16_t)0; }
        for (int e = tid; e < 64 * 16; e += 512) { const int i = e >> 4, d = 48 + (e & 15); cumf[i * 64 + d] = 0.f; cumb[i * 64 + d] = 0.f; }
        LBAR();
        { const int dirA = w >> 2, mtA = w & 3; const LAS bf16_t* Wt = dirA ? WtB : WtF; LAS float* cu = dirA ? cumb : cumf; const float* bia = dirA ? bab : baf;
#pragma unroll
          for (int nt = 0; nt < 3; ++nt) { f32x4 a = {0.f, 0.f, 0.f, 0.f}; a = mma_tile<32>(LR + mtA * 16 * 40, 40, Wt + nt * 16 * 40, 40, a, r, q); const float bz = bia[nt * 16 + r];
#pragma unroll
              for (int j = 0; j < 4; ++j) cu[(mtA * 16 + q * 4 + j) * 64 + nt * 16 + r] = logsig_(a[j] + bz) * 0.0625f; } }
        LBAR();
        { const int d = tid & 63, sg = tid >> 6; float vf[8], vb[8]; float rf = 0.f, rb = 0.f;
#pragma unroll
          for (int j = 0; j < 8; ++j) { rf += cumf[(sg * 8 + j) * 64 + d]; vf[j] = rf; }
#pragma unroll
          for (int j = 7; j >= 0; --j) { rb += cumb[(sg * 8 + j) * 64 + d]; vb[j] = rb; }
          SEG[sg * 64 + d] = rf; SEG[512 + sg * 64 + d] = rb;
          LBAR();
          float of = 0.f, ob = 0.f;
#pragma unroll
          for (int g = 0; g < 8; ++g) { if (g < sg) of += SEG[g * 64 + d]; if (g > sg) ob += SEG[512 + g * 64 + d]; }
#pragma unroll
          for (int j = 0; j < 8; ++j) { cumf[(sg * 8 + j) * 64 + d] = vf[j] + of; cumb[(sg * 8 + j) * 64 + d] = vb[j] + ob; } }
    }
    LBAR();
    const bool rope = (kind == 0) && (cs >= 4);
    const float qs = kind ? 0.14433756729740643f : 1.f, ks = kind ? 1.f : 0.125f;
    for (int e = tid; e < 2048; e += 512) {
        const int i = e >> 5, pp = e & 31, d1 = pp < 16 ? pp : pp + 16, d2 = d1 + 16;
        const bf16_t* ur = U + (size_t)(row0 + i) * NU;
        float q1 = d1 < DK ? bf2f(ur[qoff + d1]) : 0.f, q2 = d2 < DK ? bf2f(ur[qoff + d2]) : 0.f;
        float k1 = d1 < DK ? bf2f(ur[koff + d1]) : 0.f, k2 = d2 < DK ? bf2f(ur[koff + d2]) : 0.f;
        if (rope) { const float pos = pp < 16 ? (float)(cs - 4) : (float)i; const float ang = pos * exp2f(-(float)(pp & 15) * 0.8304820237218406f);
            const float sn = __sinf(ang), cn = __cosf(ang);
            const float a = q1 * cn - q2 * sn, bq = q1 * sn + q2 * cn, c = k1 * cn - k2 * sn, dk_ = k1 * sn + k2 * cn; q1 = a; q2 = bq; k1 = c; k2 = dk_; }
        q1 *= qs; q2 *= qs; k1 *= ks; k2 *= ks;
        const float cf1 = cumf[i * 64 + d1], cf2 = cumf[i * 64 + d2], cb1 = cumb[i * 64 + d1], cb2 = cumb[i * 64 + d2];
        if (pass == 3) {
            QF[i * LP + d1] = f2bf(q1 * __expf(cf1)); QF[i * LP + d2] = f2bf(q2 * __expf(cf2));
            QB[i * LP + d1] = f2bf(q1 * __expf(cb1)); QB[i * LP + d2] = f2bf(q2 * __expf(cb2));
            KF[i * LP + d1] = f2bf(k1 * __expf(-cf1)); KF[i * LP + d2] = f2bf(k2 * __expf(-cf2));
            KB[i * LP + d1] = f2bf(k1 * __expf(-cb1)); KB[i * LP + d2] = f2bf(k2 * __expf(-cb2));
        } else {
            const float ef1 = cumf[63 * 64 + d1], ef2 = cumf[63 * 64 + d2], eb1 = cumb[d1], eb2 = cumb[d2];
            KF[d1 * LP + i] = f2bf(k1 * __expf(ef1 - cf1)); KF[d2 * LP + i] = f2bf(k2 * __expf(ef2 - cf2));
            KB[d1 * LP + i] = f2bf(k1 * __expf(eb1 - cb1)); KB[d2 * LP + i] = f2bf(k2 * __expf(eb2 - cb2));
        }
    }
    { const int nvb = DV >> 3;
      for (int e = tid; e < 64 * nvb; e += 512) { const int j = e / nvb, vb = e % nvb;
          const bf16x8 vv = *(const bf16x8*)(U + (size_t)(row0 + j) * NU + voff + vb * 8);
#pragma unroll
          for (int t = 0; t < 8; ++t) VT[(vb * 8 + t) * LP + j] = (bf16_t)vv[t]; } }
    if (pass == 1) {
        LBAR();
        const int dir = w >> 2, nt = w & 3; const LAS bf16_t* KH = dir ? KB : KF; bf16_t* So = dir ? Sb : Sf; const int d = nt * 16 + r;
        for (int mt = 0; mt < (DV >> 4); ++mt) { f32x4 acc = {0.f, 0.f, 0.f, 0.f}; acc = mma_tile<64>(VT + mt * 16 * LP, LP, KH + nt * 16 * LP, LP, acc, r, q);
            if (d < DK) {
#pragma unroll
                for (int j = 0; j < 4; ++j) So[(mt * 16 + q * 4 + j) * DK + d] = f2bf(acc[j]); } }
        if (tid < 64) dec[tid] = cumf[63 * 64 + tid]; else if (tid < 128) dec[NCH * 64 + tid - 64] = cumb[tid - 64];
        LBAR();
        return;
    }
    for (int e = tid; e < DV * 8; e += 512) { const int v = e >> 3, db = e & 7; u32x4 zf = {0u, 0u, 0u, 0u}, zb = zf;
        if (db * 8 < DK) { zf = *(const u32x4*)(Sf + v * DK + db * 8); zb = *(const u32x4*)(Sb + v * DK + db * 8); }
        *(LAS u32x4*)(STF + v * LP + db * 8) = zf; *(LAS u32x4*)(STB + v * LP + db * 8) = zb; }
    LBAR();
    { const int dir = w >> 2, rb = w & 3; const LAS bf16_t* Qd = dir ? QB : QF; const LAS bf16_t* Kd = dir ? KB : KF; LAS bf16_t* Pd = dir ? PB : PF;
#pragma unroll
      for (int nt = 0; nt < 4; ++nt) { f32x4 acc = {0.f, 0.f, 0.f, 0.f}; acc = mma_tile<64>(Qd + rb * 16 * LP, LP, Kd + nt * 16 * LP, LP, acc, r, q);
#pragma unroll
          for (int j = 0; j < 4; ++j) { const int i = rb * 16 + q * 4 + j, jj = nt * 16 + r; const bool keep = dir ? (jj >= i) : (jj <= i); Pd[i * LP + jj] = f2bf(keep ? acc[j] : 0.f); } } }
    LBAR();
    const int rb = w & 3, ch = w >> 2, NT = DV >> 5;
    f32x4 acc[3];
#pragma unroll
    for (int nt = 0; nt < 3; ++nt) { acc[nt] = (f32x4){0.f, 0.f, 0.f, 0.f};
        if (nt < NT) { const int v0 = (ch * NT + nt) * 16;
            acc[nt] = mma_tile<64>(PF + rb * 16 * LP, LP, VT + v0 * LP, LP, acc[nt], r, q);
            acc[nt] = mma_tile<64>(PB + rb * 16 * LP, LP, VT + v0 * LP, LP, acc[nt], r, q);
            acc[nt] = mma_tile<64>(QF + rb * 16 * LP, LP, STF + v0 * LP, LP, acc[nt], r, q);
            acc[nt] = mma_tile<64>(QB + rb * 16 * LP, LP, STB + v0 * LP, LP, acc[nt], r, q); } }
    float s1[4], s2[4];
#pragma unroll
    for (int j = 0; j < 4; ++j) { s1[j] = acc[0][j] + acc[1][j] + acc[2][j]; s2[j] = acc[0][j] * acc[0][j] + acc[1][j] * acc[1][j] + acc[2][j] * acc[2][j];
        s1[j] = row16_sum(s1[j]); s2[j] = row16_sum(s2[j]); }
    if (r == 0) {
#pragma unroll
        for (int j = 0; j < 4; ++j) { red[((rb * 2 + ch) * 16 + q * 4 + j) * 2] = s1[j]; red[((rb * 2 + ch) * 16 + q * 4 + j) * 2 + 1] = s2[j]; } }
    LBAR();
    const float invdv = 1.f / (float)DV;
#pragma unroll
    for (int j = 0; j < 4; ++j) { const int rr = q * 4 + j;
        const float t1 = red[((rb * 2) * 16 + rr) * 2] + red[((rb * 2 + 1) * 16 + rr) * 2], t2 = red[((rb * 2) * 16 + rr) * 2 + 1] + red[((rb * 2 + 1) * 16 + rr) * 2 + 1];
        const float mean = t1 * invdv; float mu, rstd;
        if (kind == 0) { mu = mean; rstd = rsqrtf(fmaxf(t2 * invdv - mean * mean, 0.f) + 1e-5f); } else { mu = 0.f; rstd = rsqrtf(t2 * invdv + 1e-5f); }
        const int row = row0 + rb * 16 + rr;
#pragma unroll
        for (int nt = 0; nt < 3; ++nt) if (nt < NT) { const int v = (ch * NT + nt) * 16 + r;
            const float nw = kind ? p.in[opaque(16)][l * 96 + v] : p.in[opaque(11)][l * 256 + h * 64 + v];
            const float g = bf2f(U[(size_t)row * NU + goff + v]);
            Y[(size_t)row * D + ycol + v] = f2bf((acc[nt][j] - mu) * rstd * nw * siluf_(g)); } }
    LBAR();
}

__device__ __forceinline__ void la_scan(const Params& p, int vb, int nvb) {
    typedef float f32x2s __attribute__((ext_vector_type(2)));
    for (int e2 = vb * 512 + vopaque((int)threadIdx.x); e2 < 32 * 2304; e2 += nvb * 512) {
        const int chain = e2 / 2304, el = (e2 % 2304) * 2, kind = chain >> 4, dir = chain & 1;
        if (kind == 0 && el >= 4096) continue;
        const int DK = kind ? 48 : 64, d = el % DK, esz2 = kind ? 2304 : 2048;
        unsigned* S = (unsigned*)((kind ? (bf16_t*)(p.ws + (unsigned)opaque((int)WS_SGLA)) + (size_t)(chain - 16) * NCH * 4608 : (bf16_t*)(p.ws + (unsigned)opaque((int)WS_SRET)) + (size_t)chain * NCH * 4096) + el);
        const float* dec = (const float*)(p.ws + (unsigned)opaque((int)WS_DEC)) + (size_t)chain * NCH * 64 + d;
        float a0 = 0.f, a1 = 0.f;
        for (int s = 0; s < NCH; s += 12) {
            int sl[12]; unsigned t[12]; f32x2s dc[12];
#pragma unroll
            for (int u = 0; u < 12; ++u) { const int ss = s + u; sl[u] = dir ? (ss < 4 ? 3 - ss : 135 - ss) : ss; t[u] = S[(size_t)sl[u] * esz2]; dc[u] = *(const f32x2s*)(dec + sl[u] * 64); }
#pragma unroll
            for (int u = 0; u < 12; ++u) { S[(size_t)sl[u] * esz2] = pk2(a0, a1); a0 = a0 * __expf(dc[u].x) + __uint_as_float(t[u] << 16); a1 = a1 * __expf(dc[u].y) + __uint_as_float(t[u] & 0xffff0000u); }
        }
    }
}

__device__ __forceinline__ float rw_conv(const bf16_t* U, const float* cw, int row, int t, int tmax, int col) {
    const bf16_t* uc = U + (size_t)row * NU + 2208 + col; float x = cw[1472 + col] * bf2f(uc[0]);
    if (t > 0) x += cw[col] * bf2f(uc[-NU]);
    if (t + 1 < tmax) x += cw[2944 + col] * bf2f(uc[NU]);
    return x;
}
__device__ __forceinline__ float lwdec_(float z) { const float sp = (-z > 20.f) ? -z : __logf(1.f + __expf(-z)); return -__expf(-sp - 0.5f); }
__device__ __forceinline__ float tanh_(float x) { return 1.f - 2.f / (__expf(2.f * x) + 1.f); }
__device__ __forceinline__ u32x2 pack4(const f32x4 a) { u32x2 o; o.x = pk2(a[0], a[1]); o.y = pk2(a[2], a[3]); return o; }
__device__ __forceinline__ f32x4 unpack4(const u32x2 v) { f32x4 a; a[0] = __uint_as_float(v.x << 16); a[1] = __uint_as_float(v.x & 0xffff0000u); a[2] = __uint_as_float(v.y << 16); a[3] = __uint_as_float(v.y & 0xffff0000u); return a; }

typedef _Float16 half8_t __attribute__((ext_vector_type(8)));
typedef _Float16 half2_t __attribute__((ext_vector_type(2)));
__device__ __forceinline__ float clamph(float x) { return fminf(fmaxf(x, -60000.f), 60000.f); }
__device__ __forceinline__ bf16_t f2h(float f);
__device__ __forceinline__ unsigned pk2h(float lo, float hi) { return (unsigned)f2h(lo) | ((unsigned)f2h(hi) << 16); }
__device__ __forceinline__ bf16_t f2h(float f) { return __builtin_bit_cast(unsigned short, (_Float16)f); }
__device__ __forceinline__ u32x2 pack4h(const f32x4 a) { u32x2 o; o.x = pk2h(a[0], a[1]); o.y = pk2h(a[2], a[3]); return o; }
__device__ __forceinline__ float h2f_(unsigned short b) { return (float)__builtin_bit_cast(_Float16, b); }
__device__ __forceinline__ f32x4 unpack4h(const u32x2 v) { f32x4 a; a[0] = h2f_((unsigned short)(v.x & 0xffffu)); a[1] = h2f_((unsigned short)(v.x >> 16)); a[2] = h2f_((unsigned short)(v.y & 0xffffu)); a[3] = h2f_((unsigned short)(v.y >> 16)); return a; }
__device__ __forceinline__ float expc_(float x) { return __expf(fminf(x, 8.f)); }
template <int K> __device__ __forceinline__ f32x4 mma_tile_h(const LAS bf16_t* A, int lda, const LAS bf16_t* Bt, int ldb, f32x4 acc, int r, int q) {
#pragma unroll
    for (int k0 = 0; k0 < K; k0 += 32) {
        const bf16x8 a = *(const LAS bf16x8*)(A + r * lda + k0 + q * 8);
        const bf16x8 b = *(const LAS bf16x8*)(Bt + r * ldb + k0 + q * 8);
        acc = __builtin_amdgcn_mfma_f32_16x16x32_f16(__builtin_bit_cast(half8_t, a), __builtin_bit_cast(half8_t, b), acc, 0, 0, 0);
    }
    return acc;
}
__device__ __forceinline__ void w2t_phase(const Params& p, int l, int bid, int G) {
    bf16_t* o = (bf16_t*)(p.ws + (unsigned)opaque((int)WS_W2T));
    for (int e = bid * 512 + vopaque((int)threadIdx.x); e < 6 * 20480; e += G * 512) { const int h = e / 20480, x = e % 20480; float v;
        if (x < 12288) { const int which = x >> 12, hd = (x >> 6) & 63, rr = x & 63; const float* src = which == 0 ? p.in[opaque(23)] : which == 1 ? p.in[opaque(19)] : p.in[opaque(21)]; v = src[(size_t)l * 64 * 384 + rr * 384 + h * 64 + hd]; }
        else { const int y = x - 12288, hd = y >> 7, rr = y & 127; v = p.in[opaque(24)][(size_t)l * 128 * 384 + rr * 384 + h * 64 + hd]; }
        o[e] = f2h(v); }
}

__device__ __forceinline__ void lr_pre_phase(const Params& p, int l, int bid, int G) {
    bf16_t* U = (bf16_t*)(p.ws + (unsigned)opaque((int)WS_U)); bf16_t* ACT = (bf16_t*)(p.ws + (unsigned)opaque((int)WS_ACT));
    const float* cw = p.in[opaque(17)] + l * 3 * 1472;
    for (int e = bid * 512 + vopaque((int)threadIdx.x); e < MALL * 40; e += G * 512) { const int m = e / 40, c0 = (e % 40) * 8, col = 1152 + c0;
        const int t = m < MLAT ? (m & (SEQ - 1)) : ((m - MLAT) & (CTXL - 1)), tmax = m < MLAT ? SEQ : CTXL;
        const bf16_t* uc = U + (size_t)m * NU + 2208 + col;
        const bf16x8 zz = {0, 0, 0, 0, 0, 0, 0, 0};
        const bf16x8 u0 = *(const bf16x8*)uc, um = (t > 0) ? *(const bf16x8*)(uc - NU) : zz, up = (t + 1 < tmax) ? *(const bf16x8*)(uc + NU) : zz;
        float x[8];
#pragma unroll
        for (int hh = 0; hh < 2; ++hh) { const f32x4 wm = *(const f32x4*)(cw + col + 4 * hh), w0 = *(const f32x4*)(cw + 1472 + col + 4 * hh), wp = *(const f32x4*)(cw + 2944 + col + 4 * hh);
#pragma unroll
            for (int j = 0; j < 4; ++j) x[4 * hh + j] = wm[j] * bf2f((bf16_t)um[4 * hh + j]) + w0[j] * bf2f((bf16_t)u0[4 * hh + j]) + wp[j] * bf2f((bf16_t)up[4 * hh + j]); }
        if (c0 < 128) {
#pragma unroll
            for (int j = 0; j < 8; ++j) x[j] = tanh_(x[j]); }
        else if (c0 >= 192) {
#pragma unroll
            for (int j = 0; j < 8; ++j) x[j] = sigmoidf_(x[j]); }
        u32x4 o; o.x = pk2h(x[0], x[1]); o.y = pk2h(x[2], x[3]); o.z = pk2h(x[4], x[5]); o.w = pk2h(x[6], x[7]);
        bf16_t* dst = c0 < 128 ? U + (size_t)m * NU + 3680 + c0 : ACT + (size_t)m * 192 + c0 - 128;
        *(u32x4*)dst = o; }
}

__device__ __forceinline__ void ldfrag2(const LAS bf16_t* M, int row0, int r, int q, bf16x8 (&f)[2]) { f[0] = *(const LAS bf16x8*)(M + (row0 + r) * LP + q * 8); f[1] = *(const LAS bf16x8*)(M + (row0 + r) * LP + 32 + q * 8); }
__device__ __forceinline__ f32x4 mm2h(const bf16x8 (&a)[2], const bf16x8 (&b)[2], f32x4 acc) {
    acc = __builtin_amdgcn_mfma_f32_16x16x32_f16(__builtin_bit_cast(half8_t, a[0]), __builtin_bit_cast(half8_t, b[0]), acc, 0, 0, 0);
    acc = __builtin_amdgcn_mfma_f32_16x16x32_f16(__builtin_bit_cast(half8_t, a[1]), __builtin_bit_cast(half8_t, b[1]), acc, 0, 0, 0); return acc; }
constexpr int SLB = 9216;
#define SLOT(n) ((LAS bf16_t*)(lds + (n) * SLB))
template <bool PC> __device__ __forceinline__ void rw_item(const Params& p, int l, int idx, bool last, LAS unsigned char* lds) {
    const int tid = vopaque((int)threadIdx.x), lane = tid & 63, w = tid >> 6, r = lane & 15, q = lane >> 4;
    const int b = idx / 792, rem = idx % 792, cs = rem / 6, h = rem % 6;
    if (PC && last && cs < 4) return;
    const int row0 = chunk_row0(b, cs), t0 = cs < 4 ? cs * 64 : (cs - 4) * 64, tmax = cs < 4 ? CTXL : SEQ;
    const bf16_t* U = (const bf16_t*)(p.ws + (unsigned)opaque((int)WS_U));
    const float* cw = p.in[opaque(17)] + l * 3 * 1472;
    float ur[10], uk[10], uv[10];
#pragma unroll
    for (int jr = 0; jr < 10; ++jr) { const int i = w * 8 + jr - 1, t = t0 + i; const bool ok = (t >= 0) && (t < tmax);
        const bf16_t* up_ = U + (size_t)(row0 + (ok ? i : 0)) * NU + 2208 + h * 64 + lane;
        const bf16_t x0 = up_[0], x1 = up_[384], x2 = up_[768];
        ur[jr] = ok ? bf2f(x0) : 0.f; uk[jr] = ok ? bf2f(x1) : 0.f; uv[jr] = ok ? bf2f(x2) : 0.f; }
    const int hc = l * 384 + h * 64 + lane;
    const float a0v = p.in[opaque(22)][hc], w0fv = p.in[opaque(18)][hc], w0bv = p.in[opaque(20)][hc], kkv = p.in[opaque(25)][hc], kav = p.in[opaque(26)][hc], rkv = p.in[opaque(27)][hc];
    u32x4 hv0 = {0u, 0u, 0u, 0u}, hv1 = hv0;
    if (PC) { const bf16_t* Nb = (const bf16_t*)(p.ws + (unsigned)opaque((int)WS_RWN)) + ((size_t)((b * 6 + h) * 2) * NCH + cs) * 4096 + (tid >> 3) * 64 + (tid & 7) * 8;
        hv0 = *(const u32x4*)Nb; hv1 = *(const u32x4*)(Nb + (size_t)NCH * 4096); }
    LAS float* ZA = (LAS float*)lds; LAS float* ZF = ZA + 4096; LAS float* ZB = ZF + 4096; LAS float* ZG = ZB + 4096;
    LAS bf16_t* LAa = (LAS bf16_t*)(lds + 65536); LAS bf16_t* LWF = LAa + 64 * LP; LAS bf16_t* LWB = LWF + 64 * LP; LAS bf16_t* LGs = LWB + 64 * LP;
    LAS bf16_t* A2T = LGs + 64 * 136; LAS bf16_t* WFT = A2T + 64 * LP; LAS bf16_t* WBT = WFT + 64 * LP; LAS bf16_t* G2T = WBT + 64 * LP;
    { constexpr int NG = (PC ? 320 : 192) / 8;
      const bf16_t* ACT = (const bf16_t*)(p.ws + (unsigned)opaque((int)WS_ACT));
      for (int e = tid; e < 64 * NG; e += 512) { const int i = e / NG, c0 = (e % NG) * 8;
          const u32x4 v = c0 < 128 ? *(const u32x4*)(U + (size_t)(row0 + i) * NU + 3680 + c0) : *(const u32x4*)(ACT + (size_t)(row0 + i) * 192 + c0 - 128);
          LAS bf16_t* dst = c0 < 64 ? LWF + i * LP + c0 : c0 < 128 ? LWB + i * LP + c0 - 64 : c0 < 192 ? LAa + i * LP + c0 - 128 : LGs + i * 136 + c0 - 192;
          *(LAS u32x4*)dst = v; } }
    { const bf16_t* wt = (const bf16_t*)(p.ws + (unsigned)opaque((int)WS_W2T)) + (size_t)h * 20480; const int row = tid >> 3, ch = tid & 7;
      *(LAS u32x4*)(A2T + row * LP + ch * 8) = *(const u32x4*)(wt + row * 64 + ch * 8);
      *(LAS u32x4*)(WFT + row * LP + ch * 8) = *(const u32x4*)(wt + 4096 + row * 64 + ch * 8);
      *(LAS u32x4*)(WBT + row * LP + ch * 8) = *(const u32x4*)(wt + 8192 + row * 64 + ch * 8);
      if (PC) for (int e = tid; e < 1024; e += 512) { const int rw = e >> 4, c2 = e & 15; *(LAS u32x4*)(G2T + rw * 136 + c2 * 8) = *(const u32x4*)(wt + 12288 + rw * 128 + c2 * 8); } }
    LBAR();
#pragma unroll
    for (int tt = 0; tt < 2; ++tt) { const int t = w * 2 + tt, mt = t >> 2, nt = t & 3, o = (mt * 16 + q * 4) * 64 + nt * 16 + r;
        f32x4 a = {0.f, 0.f, 0.f, 0.f}; a = mma_tile_h<64>(LAa + mt * 16 * LP, LP, A2T + nt * 16 * LP, LP, a, r, q);
#pragma unroll
        for (int j = 0; j < 4; ++j) ZA[o + j * 64] = a[j];
        a = (f32x4){0.f, 0.f, 0.f, 0.f}; a = mma_tile_h<64>(LWF + mt * 16 * LP, LP, WFT + nt * 16 * LP, LP, a, r, q);
#pragma unroll
        for (int j = 0; j < 4; ++j) ZF[o + j * 64] = a[j];
        a = (f32x4){0.f, 0.f, 0.f, 0.f}; a = mma_tile_h<64>(LWB + mt * 16 * LP, LP, WBT + nt * 16 * LP, LP, a, r, q);
#pragma unroll
        for (int j = 0; j < 4; ++j) ZB[o + j * 64] = a[j];
        if (PC) { a = (f32x4){0.f, 0.f, 0.f, 0.f}; a = mma_tile_h<128>(LGs + mt * 16 * 136, 136, G2T + nt * 16 * 136, 136, a, r, q);
#pragma unroll
            for (int j = 0; j < 4; ++j) ZG[o + j * 64] = a[j]; } }
    LBAR();
    float R_[8], K2[8], V_[8], KN[8], BE[8], LF[8], LB[8], GG[8], BO[8];
    {
      const int cc = h * 64 + lane;
      const float cr0 = cw[cc], cr1 = cw[1472 + cc], cr2 = cw[2944 + cc], ck0 = cw[384 + cc], ck1 = cw[1472 + 384 + cc], ck2 = cw[2944 + 384 + cc], cv0 = cw[768 + cc], cv1 = cw[1472 + 768 + cc], cv2 = cw[2944 + 768 + cc];
#pragma unroll
      for (int jj = 0; jj < 8; ++jj) { const int i = w * 8 + jj;
          const float rv = cr0 * ur[jj] + cr1 * ur[jj + 1] + cr2 * ur[jj + 2], kv = ck0 * uk[jj] + ck1 * uk[jj + 1] + ck2 * uk[jj + 2], vv = cv0 * uv[jj] + cv1 * uv[jj + 1] + cv2 * uv[jj + 2];
          const float a = sigmoidf_(a0v + ZA[i * 64 + lane]);
          LF[jj] = lwdec_(w0fv + ZF[i * 64 + lane]); LB[jj] = lwdec_(w0bv + ZB[i * 64 + lane]);
          float kk = kv * kkv; const float n2 = wave_sum(kk * kk); kk *= rsqrtf(fmaxf(n2, 1e-24f));
          const float k2 = kv * (1.f + (a - 1.f) * kav);
          R_[jj] = rv; K2[jj] = k2; V_[jj] = vv; KN[jj] = kk; BE[jj] = kk * a;
          if (PC) { GG[jj] = ZG[i * 64 + lane]; BO[jj] = wave_sum(rv * k2 * rkv) * vv; } else { GG[jj] = 0.f; BO[jj] = 0.f; } } }
    LBAR();
    LAS float* TOT = (LAS float*)(lds + 17 * SLB);
    LAS bf16_t* AB = SLOT(0); LAS bf16_t* BBm = SLOT(1); LAS bf16_t* KBm = SLOT(2); LAS bf16_t* S3 = SLOT(3); LAS bf16_t* VT = SLOT(4); LAS bf16_t* S5 = SLOT(5);
    LAS bf16_t* XP = SLOT(6); LAS bf16_t* XPT = SLOT(7); LAS bf16_t* XST = SLOT(8); LAS bf16_t* YP = SLOT(9); LAS bf16_t* YPT = SLOT(10); LAS bf16_t* YST = SLOT(11);
    LAS bf16_t* AAK = SLOT(12); LAS bf16_t* ARB = SLOT(13); LAS bf16_t* ARK = SLOT(14);
    LAS bf16_t* XT = PC ? SLOT(15) : SLOT(13);
    LAS bf16_t* UT = PC ? SLOT(16) : SLOT(15);
    f32x4 Of[2] = {{0.f, 0.f, 0.f, 0.f}, {0.f, 0.f, 0.f, 0.f}};
    const int mtw = w >> 1, ntw = (w & 1) * 2;
    for (int dir = 0; dir < 2; ++dir) {
        const int cd = ((b * 6 + h) * 2 + dir) * NCH + cs;
        constexpr bool useT = PC;
        bf16_t* Mg = (bf16_t*)(p.ws + (unsigned)opaque((int)WS_RWM)) + (size_t)cd * 4096; bf16_t* Ng = (bf16_t*)(p.ws + (unsigned)opaque((int)WS_RWN)) + (size_t)cd * 4096; float* Pg = (float*)(p.ws + (unsigned)opaque((int)WS_RWP)) + (size_t)cd * 64;
        float cum[8]; float run = 0.f;
        if (dir == 0) {
#pragma unroll
            for (int jj = 0; jj < 8; ++jj) { run += LF[jj]; cum[jj] = run; } }
        else {
#pragma unroll
            for (int jj = 7; jj >= 0; --jj) { run += LB[jj]; cum[jj] = run; } }
        TOT[w * 64 + lane] = run;
        LBAR();
        float off = 0.f, cumtot = 0.f;
#pragma unroll
        for (int ww = 0; ww < 8; ++ww) { const float tv = TOT[ww * 64 + lane]; cumtot += tv; if (dir == 0 ? (ww < w) : (ww > w)) off += tv; }
        LAS float* CR = TOT + 512;
        if (dir == 0 ? (w == 3) : (w == 4)) CR[lane] = (dir == 0 ? cum[7] : cum[0]) + off;
        LBAR();
        const float cref = CR[lane];
#pragma unroll
        for (int jj = 0; jj < 8; ++jj) { const int i = w * 8 + jj, pp = dir ? 63 - i : i; const float lw = dir ? LB[jj] : LF[jj], cj = cum[jj] + off;
            const float al = -KN[jj] * expc_(cj - lw - cref), einv = expc_(cref - cj);
            AB[pp * LP + lane] = f2h(al); BBm[pp * LP + lane] = f2h(BE[jj] * einv); KBm[pp * LP + lane] = f2h(K2[jj] * einv);
            VT[lane * LP + pp] = f2h(V_[jj]);
            if (PC) S3[pp * LP + lane] = f2h(R_[jj] * expc_(cj - cref));
            else { const float ee = __expf(cumtot - cj); S3[lane * LP + pp] = f2h(BE[jj] * ee); S5[lane * LP + pp] = f2h(K2[jj] * ee); XT[lane * LP + pp] = f2h(al); } }
        if (useT) { const int row = tid >> 3, ch = tid & 7; u32x4 tv = {0u, 0u, 0u, 0u};
            if (dir == 0) tv = *(const u32x4*)((const bf16_t*)(p.ws + (unsigned)opaque((int)WS_Y)) + (size_t)(row0 + row) * D + 640 + h * 64 + ch * 8);
            else { const int mt = row >> 4, nt = ch >> 1; if (nt <= mt) { const int tile = (mt * (mt + 1)) / 2 + nt, l16 = (row & 15) * 2 + (ch & 1); tv = *(const u32x4*)(U + (size_t)(row0 + h * 10 + tile) * NU + 3360 + l16 * 8); } }
            *(LAS u32x4*)(XP + row * LP + ch * 8) = tv; }
        if (PC) { const int row = tid >> 3, ch = tid & 7; const u32x4 hv = dir ? hv1 : hv0;
            const f32x4 h0 = unpack4h((u32x2){hv.x, hv.y}), h1 = unpack4h((u32x2){hv.z, hv.w}); const f32x4 e0 = *(const LAS f32x4*)(CR + ch * 8), e1 = *(const LAS f32x4*)(CR + ch * 8 + 4);
            f32x4 g0, g1;
#pragma unroll
            for (int j = 0; j < 4; ++j) { g0[j] = h0[j] * __expf(e0[j]); g1[j] = h1[j] * __expf(e1[j]); }
            const u32x2 p0 = pack4h(g0), p1 = pack4h(g1); *(LAS u32x4*)(S5 + row * LP + ch * 8) = (u32x4){p0.x, p0.y, p1.x, p1.y}; }
        LBAR();
        { bf16x8 fA[2], fR[2]; ldfrag2(AB, mtw * 16, r, q, fA); if (PC) ldfrag2(S3, mtw * 16, r, q, fR);
#pragma unroll
          for (int tt = 0; tt < 2; ++tt) { const int nt = ntw + tt, pp0 = mtw * 16 + q * 4, ss = nt * 16 + r;
            bf16x8 fB[2], fK[2]; ldfrag2(BBm, nt * 16, r, q, fB); ldfrag2(KBm, nt * 16, r, q, fK);
            f32x4 a;
            if (!useT) { a = mm2h(fA, fB, (f32x4){0.f, 0.f, 0.f, 0.f});
#pragma unroll
                for (int j = 0; j < 4; ++j) { a[j] = (ss < pp0 + j) ? a[j] : 0.f; XP[(pp0 + j) * LP + ss] = f2h(a[j]); }
                *(LAS u32x2*)(XPT + ss * LP + pp0) = pack4h(a);
#pragma unroll
                for (int j = 0; j < 4; ++j) a[j] = (ss == pp0 + j) ? 1.f : a[j];
                *(LAS u32x2*)(YST + ss * LP + pp0) = pack4h(a); }
            a = mm2h(fA, fK, (f32x4){0.f, 0.f, 0.f, 0.f});
#pragma unroll
            for (int j = 0; j < 4; ++j) AAK[(pp0 + j) * LP + ss] = f2h((ss < pp0 + j) ? a[j] : 0.f);
            if (PC) {
                a = mm2h(fR, fB, (f32x4){0.f, 0.f, 0.f, 0.f});
#pragma unroll
                for (int j = 0; j < 4; ++j) ARB[(pp0 + j) * LP + ss] = f2h((ss <= pp0 + j) ? a[j] : 0.f);
                a = mm2h(fR, fK, (f32x4){0.f, 0.f, 0.f, 0.f});
#pragma unroll
                for (int j = 0; j < 4; ++j) ARK[(pp0 + j) * LP + ss] = f2h((ss <= pp0 + j) ? a[j] : 0.f); } } }
        LBAR();
        { bf16x8 fP[2], fAk[2], fAb[2]; if (!useT) ldfrag2(XP, mtw * 16, r, q, fP); else { fP[0] = (bf16x8){0,0,0,0,0,0,0,0}; fP[1] = fP[0]; } ldfrag2(AAK, mtw * 16, r, q, fAk); if (PC) ldfrag2(AB, mtw * 16, r, q, fAb);
#pragma unroll
          for (int tt = 0; tt < 2; ++tt) { const int nt = ntw + tt, pp0 = mtw * 16 + q * 4, ss = nt * 16 + r;
            bf16x8 fT[2], fV[2]; if (!useT) ldfrag2(XPT, nt * 16, r, q, fT); else { fT[0] = (bf16x8){0,0,0,0,0,0,0,0}; fT[1] = fT[0]; } ldfrag2(VT, nt * 16, r, q, fV);
            if (!useT) { const f32x4 c = mm2h(fP, fT, (f32x4){0.f, 0.f, 0.f, 0.f});
#pragma unroll
                for (int j = 0; j < 4; ++j) YP[(pp0 + j) * LP + ss] = f2h(c[j]);
                *(LAS u32x2*)(YPT + ss * LP + pp0) = pack4h(c); }
            f32x4 x = mm2h(fAk, fV, (f32x4){0.f, 0.f, 0.f, 0.f});
            if (PC) { bf16x8 fH[2]; ldfrag2(S5, nt * 16, r, q, fH); x = mm2h(fAb, fH, x); *(LAS u32x2*)(XT + ss * LP + pp0) = pack4h(x); }
            else *(LAS u32x2*)(XT + (64 + ss) * LP + pp0) = pack4h(x); } }
        LBAR();
        if (!useT) for (int k = 1; k <= 5; ++k) {
            LAS bf16_t* sP = (k & 1) ? YP : XP; LAS bf16_t* sPT = (k & 1) ? YPT : XPT; LAS bf16_t* sST = (k & 1) ? YST : XST;
            LAS bf16_t* dP = (k & 1) ? XP : YP; LAS bf16_t* dPT = (k & 1) ? XPT : YPT; LAS bf16_t* dST = (k & 1) ? XST : YST;
            bf16x8 fP[2]; ldfrag2(sP, mtw * 16, r, q, fP);
#pragma unroll
            for (int tt = 0; tt < 2; ++tt) { const int nt = ntw + tt, pp0 = mtw * 16 + q * 4, ss = nt * 16 + r;
                bf16x8 fS[2]; ldfrag2(sST, nt * 16, r, q, fS);
                f32x4 a = unpack4h(*(const LAS u32x2*)(sST + ss * LP + pp0));
                a = mm2h(fP, fS, a);
                if (k < 5) {
                    *(LAS u32x2*)(dST + ss * LP + pp0) = pack4h(a);
                    bf16x8 fT[2]; ldfrag2(sPT, nt * 16, r, q, fT);
                    const f32x4 c = mm2h(fP, fT, (f32x4){0.f, 0.f, 0.f, 0.f});
#pragma unroll
                    for (int j = 0; j < 4; ++j) dP[(pp0 + j) * LP + ss] = f2h(c[j]);
                    *(LAS u32x2*)(dPT + ss * LP + pp0) = pack4h(c);
                } else {
#pragma unroll
                    for (int j = 0; j < 4; ++j) dP[(pp0 + j) * LP + ss] = f2h(a[j]); } }
            LBAR();
        }
        if (!PC && dir == 0) { const int row = tid >> 3, ch = tid & 7; *(u32x4*)((bf16_t*)(p.ws + (unsigned)opaque((int)WS_Y)) + (size_t)(row0 + row) * D + 640 + h * 64 + ch * 8) = *(const LAS u32x4*)(XP + row * LP + ch * 8); }
        if (!PC && dir == 1 && tid < 320) { const int tile = tid >> 5, l16 = tid & 31, mt = tile < 1 ? 0 : tile < 3 ? 1 : tile < 6 ? 2 : 3, nt = tile - (mt * (mt + 1)) / 2;
            *(u32x4*)((bf16_t*)(p.ws + (unsigned)opaque((int)WS_U)) + (size_t)(row0 + h * 10 + tile) * NU + 3360 + l16 * 8) = *(const LAS u32x4*)(XP + (mt * 16 + (l16 >> 1)) * LP + nt * 16 + (l16 & 1) * 8); }
        if (!PC) {
#pragma unroll
            for (int mt = 0; mt < 4; ++mt) { f32x4 a = {0.f, 0.f, 0.f, 0.f}; a = mma_tile_h<64>(XP + mt * 16 * LP, LP, XT + (w * 16) * LP, LP, a, r, q);
                *(LAS u32x2*)(UT + (w * 16 + r) * LP + mt * 16 + q * 4) = pack4h(a); }
            LBAR();
#pragma unroll
            for (int tt = 0; tt < 2; ++tt) { const int nt = ntw + tt;
                f32x4 a = {0.f, 0.f, 0.f, 0.f}; a = mma_tile_h<64>(S3 + mtw * 16 * LP, LP, UT + nt * 16 * LP, LP, a, r, q);
#pragma unroll
                for (int j = 0; j < 4; ++j) Mg[(mtw * 16 + q * 4 + j) * 64 + nt * 16 + r] = f2h(a[j] * __expf(CR[nt * 16 + r]));
                f32x4 n = {0.f, 0.f, 0.f, 0.f}; n = mma_tile_h<64>(S3 + mtw * 16 * LP, LP, UT + (64 + nt * 16) * LP, LP, n, r, q);
                n = mma_tile_h<64>(S5 + mtw * 16 * LP, LP, VT + nt * 16 * LP, LP, n, r, q);
                *(u32x2*)(Ng + (nt * 16 + r) * 64 + mtw * 16 + q * 4) = pack4h(n); }
            if (w == 0) Pg[lane] = __expf(cumtot);
            LBAR();
        } else {
            bf16x8 fTT[2]; ldfrag2(XP, mtw * 16, r, q, fTT);
#pragma unroll
            for (int tt = 0; tt < 2; ++tt) { const int nt = ntw + tt; bf16x8 fX[2]; ldfrag2(XT, nt * 16, r, q, fX); const f32x4 a = mm2h(fTT, fX, (f32x4){0.f, 0.f, 0.f, 0.f});
                *(LAS u32x2*)(UT + (nt * 16 + r) * LP + mtw * 16 + q * 4) = pack4h(a); }
            LBAR();
            f32x4 o[2];
            bf16x8 fRB[2], fARB[2], fARK[2]; ldfrag2(S3, mtw * 16, r, q, fRB); ldfrag2(ARB, mtw * 16, r, q, fARB); ldfrag2(ARK, mtw * 16, r, q, fARK);
#pragma unroll
            for (int tt = 0; tt < 2; ++tt) { const int nt = ntw + tt; bf16x8 fH[2], fU[2], fV[2]; ldfrag2(S5, nt * 16, r, q, fH); ldfrag2(UT, nt * 16, r, q, fU); ldfrag2(VT, nt * 16, r, q, fV);
                f32x4 a = mm2h(fRB, fH, (f32x4){0.f, 0.f, 0.f, 0.f}); a = mm2h(fARB, fU, a); a = mm2h(fARK, fV, a); o[tt] = a; }
            if (dir == 0) { Of[0] = o[0]; Of[1] = o[1]; LBAR(); }
            else {
                LBAR();
                LAS float* OS = (LAS float*)SLOT(6);
#pragma unroll
                for (int tt = 0; tt < 2; ++tt)
#pragma unroll
                    for (int j = 0; j < 4; ++j) OS[(mtw * 16 + q * 4 + j) * 64 + (ntw + tt) * 16 + r] = Of[tt][j];
                LBAR();
#pragma unroll
                for (int tt = 0; tt < 2; ++tt)
#pragma unroll
                    for (int j = 0; j < 4; ++j) OS[(63 - (mtw * 16 + q * 4 + j)) * 64 + (ntw + tt) * 16 + r] += o[tt][j];
                LBAR();
            }
        }
    }
    if (PC) {
        const LAS float* OS = (const LAS float*)SLOT(6); bf16_t* Y = (bf16_t*)(p.ws + (unsigned)opaque((int)WS_Y));
        const float lnw = p.in[opaque(28)][l * 384 + h * 64 + lane], lnb = p.in[opaque(29)][l * 384 + h * 64 + lane];
#pragma unroll
        for (int jj = 0; jj < 8; ++jj) { const int i = w * 8 + jj; const float o = OS[i * 64 + lane];
            const float mu = wave_sum(o) * (1.f / 64.f), dl = o - mu, var = wave_sum(dl * dl) * (1.f / 64.f);
            const float yv = dl * rsqrtf(var + 64e-5f) * lnw + lnb + BO[jj];
            Y[(size_t)(row0 + i) * D + 640 + h * 64 + lane] = f2bf(yv * GG[jj]); }
        LBAR();
    }
}

__device__ __forceinline__ void rw_passB(const Params& p, int unit, LAS unsigned char* lds) {
    const int tid = vopaque((int)threadIdx.x), lane = tid & 63, w = tid >> 6, r = lane & 15, q = lane >> 4;
    const int chain = unit >> 2, vs = unit & 3, dir = chain & 1, mt = w & 3; const bool act = w < 4;
    const bf16_t* Mg = (const bf16_t*)(p.ws + (unsigned)opaque((int)WS_RWM)) + (size_t)chain * NCH * 4096 + (mt * 16 + r) * 64 + q * 8;
    bf16_t* Ng = (bf16_t*)(p.ws + (unsigned)opaque((int)WS_RWN)) + (size_t)chain * NCH * 4096 + (vs * 16 + r) * 64 + mt * 16 + q * 4;
    const float* Pg = (const float*)(p.ws + (unsigned)opaque((int)WS_RWP)) + (size_t)chain * NCH * 64 + mt * 16 + q * 4;
    f32x4 hacc = {0.f, 0.f, 0.f, 0.f};
    bf16x8 Mq[6][2]; u32x2 Nq[6]; f32x4 Pq[6];
#define PB_LOAD(set, sidx) do { const int s_ = (sidx) < NCH ? (sidx) : NCH - 1; const int c_ = dir ? (s_ < 4 ? 3 - s_ : 135 - s_) : s_; \
        Mq[set][0] = *(const bf16x8*)(Mg + (size_t)c_ * 4096); Mq[set][1] = *(const bf16x8*)(Mg + (size_t)c_ * 4096 + 32); \
        Nq[set] = *(const u32x2*)(Ng + (size_t)c_ * 4096); Pq[set] = *(const f32x4*)(Pg + c_ * 64); } while (0)
    if (act) { PB_LOAD(0, 0); PB_LOAD(1, 1); PB_LOAD(2, 2); PB_LOAD(3, 3); PB_LOAD(4, 4); PB_LOAD(5, 5); }
    for (int s0 = 0; s0 < NCH; s0 += 6) {
#pragma unroll
        for (int u = 0; u < 6; ++u) { const int s = s0 + u, cs = dir ? (s < 4 ? 3 - s : 135 - s) : s;
            LAS bf16_t* HT = (LAS bf16_t*)(lds + (u & 1) * 4608);
            if (act) { const u32x2 hb = pack4h(hacc); const f32x4 hl = hacc - unpack4h(hb);
                *(u32x2*)(Ng + (size_t)cs * 4096) = hb;
                *(LAS u32x2*)(HT + r * LP + mt * 16 + q * 4) = hb; *(LAS u32x2*)(HT + 16 * LP + r * LP + mt * 16 + q * 4) = pack4h(hl); }
            asm volatile("s_waitcnt lgkmcnt(0)" ::: "memory"); __builtin_amdgcn_s_barrier(); asm volatile("" ::: "memory");
            if (act) {
                const bf16x8 B0 = *(const LAS bf16x8*)(HT + r * LP + q * 8), B1 = *(const LAS bf16x8*)(HT + r * LP + 32 + q * 8);
                const bf16x8 L0 = *(const LAS bf16x8*)(HT + 16 * LP + r * LP + q * 8), L1 = *(const LAS bf16x8*)(HT + 16 * LP + r * LP + 32 + q * 8);
                f32x4 a = Pq[u] * hacc + unpack4h(Nq[u]);
                a = __builtin_amdgcn_mfma_f32_16x16x32_f16(__builtin_bit_cast(half8_t, Mq[u][0]), __builtin_bit_cast(half8_t, L0), a, 0, 0, 0);
                a = __builtin_amdgcn_mfma_f32_16x16x32_f16(__builtin_bit_cast(half8_t, Mq[u][1]), __builtin_bit_cast(half8_t, L1), a, 0, 0, 0);
                a = __builtin_amdgcn_mfma_f32_16x16x32_f16(__builtin_bit_cast(half8_t, Mq[u][0]), __builtin_bit_cast(half8_t, B0), a, 0, 0, 0);
                a = __builtin_amdgcn_mfma_f32_16x16x32_f16(__builtin_bit_cast(half8_t, Mq[u][1]), __builtin_bit_cast(half8_t, B1), a, 0, 0, 0);
                hacc = a;
                PB_LOAD(u, s + 6);
            }
        }
    }
#undef PB_LOAD
    __syncthreads();
}

#define XB_TMO      128
#define XB_XCNT(j)  (256  + 64 * (j))
#define XB_XSUB(j)  (1280 + 64 * (j))
#define XB_XGEN(j)  (2304 + 64 * (j))
#define XB_TOP      3328
#define XB_TOPGEN   3392
#define XCD_BAR_WORDS 3456
#define XB_SPIN_CAP (1u << 18)

__device__ __forceinline__ unsigned xb_ld(unsigned* p)              { return __hip_atomic_load(p, __ATOMIC_RELAXED, __HIP_MEMORY_SCOPE_AGENT); }
__device__ __forceinline__ unsigned xb_add(unsigned* p, unsigned v) { return __hip_atomic_fetch_add(p, v, __ATOMIC_RELAXED, __HIP_MEMORY_SCOPE_AGENT); }
__device__ __forceinline__ unsigned xb_xcc_id() { return (unsigned)__builtin_amdgcn_s_getreg((3 << 11) | 20) & 0xFu; }
#define XB_SPIN(cond, bar) do { unsigned _sp = 0; while (cond) { __builtin_amdgcn_s_sleep(1); \
    if ((++_sp & 255u) == 0u) { if (xb_ld(&(bar)[XB_TMO])) break; if (_sp > XB_SPIN_CAP) { atomicAdd(&(bar)[XB_TMO], 1u); break; } } } } while (0)

struct XcdBarrier {
    unsigned* bar; unsigned x;
    volatile LAS unsigned* st;
};

__device__ __forceinline__ XcdBarrier xcd_barrier_post(unsigned* bar, volatile LAS unsigned* st) {
    XcdBarrier b; b.bar = bar; b.x = xb_xcc_id(); b.st = st;
    if (threadIdx.x == 0) (void)xb_add(&bar[XB_XCNT(b.x)], 1u);
    return b;
}
__device__ __forceinline__ void xcd_barrier_complete(unsigned* bar, unsigned x, unsigned& nloc, unsigned& nx) {
    const unsigned G = gridDim.x * gridDim.y * gridDim.z;
    unsigned sum, cnt, mine, sp = 0u;
    for (;;) {
        sum = 0u; cnt = 0u; mine = 0u;
#pragma unroll
        for (unsigned j = 0; j < 16; ++j) { const unsigned c = xb_ld(&bar[XB_XCNT(j)]); sum += c; cnt += (c > 0u) ? 1u : 0u; mine = (j == x) ? c : mine; }
        if (sum == G) break;
        __builtin_amdgcn_s_sleep(1);
        if ((++sp & 255u) == 0u) { if (xb_ld(&bar[XB_TMO])) break; if (sp > XB_SPIN_CAP) { atomicAdd(&bar[XB_TMO], 1u); break; } }
    }
    nloc = mine > 0u ? mine : 1u; nx = cnt > 0u ? cnt : 1u;
}

__device__ __forceinline__ void xcd_barrier(const XcdBarrier& b) {
    asm volatile("s_waitcnt vmcnt(0)" ::: "memory");
    __syncthreads();
    if (threadIdx.x == 0) {
        unsigned* bar = b.bar;
        __builtin_amdgcn_s_waitcnt(0);
        unsigned nloc = b.st[0], nx = b.st[1];
        if (nloc == 0u) { xcd_barrier_complete(bar, b.x, nloc, nx); b.st[0] = nloc; b.st[1] = nx; }
        const unsigned old = xb_add(&bar[XB_XSUB(b.x)], 1u);
        const unsigned gen = old / nloc;
        if (old + 1u == (gen + 1u) * nloc) {
            __builtin_amdgcn_fence(__ATOMIC_RELEASE, "agent");
            asm volatile("s_waitcnt vmcnt(0)" ::: "memory");
            const unsigned og = xb_add(&bar[XB_TOP], 1u);
            const unsigned tg = og / nx;
            if (og + 1u == (tg + 1u) * nx) xb_add(&bar[XB_TOPGEN], 1u);
            else XB_SPIN(xb_ld(&bar[XB_TOPGEN]) == tg, bar);
            __builtin_amdgcn_fence(__ATOMIC_ACQUIRE, "agent");
            xb_add(&bar[XB_XGEN(b.x)], 1u);
            asm volatile("s_waitcnt vmcnt(0)" ::: "memory");
        } else {
            XB_SPIN(xb_ld(&bar[XB_XGEN(b.x)]) == gen, bar);
            __builtin_amdgcn_fence(__ATOMIC_ACQUIRE, "agent");
            asm volatile("s_waitcnt vmcnt(0)" ::: "memory");
        }
    }
    __syncthreads();
}

__device__ __forceinline__ void ctx_gemm_items(const bf16_t* A, int lda, const bf16_t* Bt, int ldb, int nkc, float* part, LAS unsigned char* lds, int bid, int G) {
    const int tid = vopaque((int)threadIdx.x), lane = tid & 63, w = tid >> 6, r = lane & 15, q = lane >> 4;
    LAS bf16_t* As = (LAS bf16_t*)lds; LAS bf16_t* Bs = As + 64 * 264;
    const int nit = 128 * nkc;
    u32x4 ra[4], rbv[4];
#define CG_LOAD(itx) do { const int it_ = (itx) < nit ? (itx) : nit - 1; const int kc_ = it_ >> 7, rb_ = (it_ >> 4) & 7, cb_ = it_ & 15; \
        _Pragma("unroll") for (int u = 0; u < 4; ++u) { const int e = tid + u * 512, row = e >> 5, ch = e & 31; \
            ra[u] = *(const u32x4*)(A + (size_t)(rb_ * 64 + row) * lda + kc_ * 256 + ch * 8); rbv[u] = *(const u32x4*)(Bt + (size_t)(cb_ * 64 + row) * ldb + kc_ * 256 + ch * 8); } } while (0)
    if (bid < nit) CG_LOAD(bid);
    for (int it = bid; it < nit; it += G) { const int kc = it >> 7, rb = (it >> 4) & 7, cb = it & 15;
#pragma unroll
        for (int u = 0; u < 4; ++u) { const int e = tid + u * 512, row = e >> 5, ch = e & 31; *(LAS u32x4*)(As + row * 264 + ch * 8) = ra[u]; *(LAS u32x4*)(Bs + row * 264 + ch * 8) = rbv[u]; }
        LBAR();
        CG_LOAD(it + G);
        const int mt = w >> 1;
#pragma unroll
        for (int tt = 0; tt < 2; ++tt) { const int nt = (w & 1) * 2 + tt; f32x4 a = {0.f, 0.f, 0.f, 0.f}; a = mma_tile<256>(As + mt * 16 * 264, 264, Bs + nt * 16 * 264, 264, a, r, q);
#pragma unroll
            for (int j = 0; j < 4; ++j) part[((size_t)kc * MCTX + rb * 64 + mt * 16 + q * 4 + j) * D + cb * 64 + nt * 16 + r] = a[j]; }
        LBAR();
    }
#undef CG_LOAD
}

__global__ void __launch_bounds__(512, 2) fwd_kernel(Params p) {
    extern __shared__ __attribute__((aligned(16))) unsigned char lds_raw[];
    LAS unsigned char* lds = (LAS unsigned char*)lds_raw;
    cg::grid_group grid = cg::this_grid();
    const int bid = blockIdx.x, G = gridDim.x;
    volatile LAS unsigned* xst = (volatile LAS unsigned*)(lds + 163824);
    if (threadIdx.x == 0) { xst[0] = 0u; xst[1] = 0u; }
    __syncthreads();
    (void)xcd_barrier_post((unsigned*)(p.ws + (unsigned)opaque((int)WS_BAR)), xst);
#define XBAR() do { XcdBarrier xb_; xb_.bar = (unsigned*)(p.ws + (unsigned)opaque((int)WS_BAR)); xb_.x = xb_xcc_id(); xb_.st = (volatile LAS unsigned*)(lds + 163824); xcd_barrier(xb_); } while (0)

    mod_phase(p, lds, bid, G);
    __syncthreads();
    wconv_items(p, 0, 0, lds, bid, G);
    if (G == 0) grid.sync();
    XBAR();
    row_phase(p.in[opaque(0)], p.in[opaque(2)], nullptr, nullptr, nullptr, 0, nullptr, nullptr, p.in[opaque(6)], ((const float*)(p.ws + (unsigned)opaque((int)WS_MOD))), 0, 1024, ((bf16_t*)(p.ws + (unsigned)opaque((int)WS_Y))), MALL, bid, G);
    XBAR();
    for (int l = 0; l < 2; ++l) {
        const bool last = (l == 1); const int M = last ? MLAT : MALL;
        w2t_phase(p, l, bid, G);
        { pg8::Gemm g{((bf16_t*)(p.ws + (unsigned)opaque((int)WS_Y))), (const bf16_t*)((p.ws + (unsigned)opaque(0)) + WS_WIN), opaque(MALL), opaque(NU), opaque(D)}; pg8::StaticOrder S; S.init(g.M, g.N, G, bid); pg8::EpiBf16<0> E{((bf16_t*)(p.ws + (unsigned)opaque((int)WS_U))), NU, nullptr, 0, 0};
          pg8::gemm_phase<pg8::EpiBf16<0>, pg8::StaticOrder>(lds, g, S, E, nullptr); }
        XBAR();
        lr_pre_phase(p, l, bid, G);
        XBAR();
        for (int it = bid; it < 1584; it += G) rw_item<false>(p, l, it, last, lds);
        {
            unsigned* ctl = (unsigned*)(p.ws + (unsigned)opaque((int)WS_BAR)) + 3456 + l * 256 + 192;
            volatile LAS unsigned* tk = (volatile LAS unsigned*)(lds + 163832);
            for (;;) {
                if (threadIdx.x == 0) tk[0] = xb_add(ctl, 1u);
                __syncthreads();
                const unsigned t = tk[0];
                __syncthreads();
                if (t >= 2112u) break;
                la_item(p, l, (int)t, 1, last, lds);
            }
        }
        wconv_items(p, l, 1, lds, bid, G);
        XBAR();
        {
            unsigned* ctl = (unsigned*)(p.ws + (unsigned)opaque((int)WS_BAR)) + 3456 + l * 256;
            volatile LAS unsigned* tk = (volatile LAS unsigned*)(lds + 163832);
            if (bid < 96) {
                rw_passB(p, bid, lds);
                asm volatile("s_waitcnt vmcnt(0)" ::: "memory"); __syncthreads();
                if (threadIdx.x == 0) { __builtin_amdgcn_fence(__ATOMIC_RELEASE, "agent"); asm volatile("s_waitcnt vmcnt(0)" ::: "memory"); (void)xb_add(ctl + 64, 1u); }
            } else {
                la_scan(p, bid - 96, G - 96);
                asm volatile("s_waitcnt vmcnt(0)" ::: "memory"); __syncthreads();
                if (threadIdx.x == 0) {
                    __builtin_amdgcn_fence(__ATOMIC_RELEASE, "agent"); asm volatile("s_waitcnt vmcnt(0)" ::: "memory");
                    (void)xb_add(ctl + 128, 1u);
                    unsigned sp = 0; while (xb_ld(ctl + 128) < (unsigned)(G - 96)) { __builtin_amdgcn_s_sleep(1); if (++sp > (1u << 22)) break; }
                    __builtin_amdgcn_fence(__ATOMIC_ACQUIRE, "agent"); asm volatile("s_waitcnt vmcnt(0)" ::: "memory");
                }
                __syncthreads();
                for (;;) {
                    if (threadIdx.x == 0) { const bool done = xb_ld(ctl + 64) >= 96u; tk[0] = done ? 0x7fffffffu : xb_add(ctl, 1u); }
                    __syncthreads();
                    const unsigned t = tk[0];
                    __syncthreads();
                    if (t >= 2112u) break;
                    la_item(p, l, (int)t, 3, last, lds);
                }
            }
        }
        XBAR();
        for (int it = bid; it < 1584; it += G) rw_item<true>(p, l, it, last, lds);
        {
            unsigned* ctl = (unsigned*)(p.ws + (unsigned)opaque((int)WS_BAR)) + 3456 + l * 256;
            volatile LAS unsigned* tk = (volatile LAS unsigned*)(lds + 163832);
            for (;;) {
                if (threadIdx.x == 0) tk[0] = xb_add(ctl, 1u);
                __syncthreads();
                const unsigned t = tk[0];
                __syncthreads();
                if (t >= 2112u) break;
                la_item(p, l, (int)t, 3, last, lds);
            }
        }
        XBAR();
        { pg8::Gemm g{((bf16_t*)(p.ws + (unsigned)opaque((int)WS_Y))), (const bf16_t*)((p.ws + (unsigned)opaque(0)) + WS_WOUT), opaque(MLAT), opaque(D), opaque(D)}; pg8::StaticOrder S; S.init(g.M, g.N, G, bid); pg8::EpiBf16<0> E{((bf16_t*)(p.ws + (unsigned)opaque((int)WS_U))), D, nullptr, 0, 0};
          pg8::gemm_phase<pg8::EpiBf16<0>, pg8::StaticOrder>(lds, g, S, E, nullptr); }
        if (!last) ctx_gemm_items(((const bf16_t*)(p.ws + (unsigned)opaque((int)WS_Y))) + (size_t)MLAT * D, D, (const bf16_t*)((p.ws + (unsigned)opaque(0)) + WS_WOUT), D, 4, ((float*)(p.ws + (unsigned)opaque((int)WS_SRET))), lds, bid, G);
        XBAR();
        row_phase(l == 0 ? p.in[opaque(0)] : p.out, l == 0 ? p.in[opaque(2)] : ((float*)(p.ws + (unsigned)opaque((int)WS_CTX))), ((const bf16_t*)(p.ws + (unsigned)opaque((int)WS_U))), p.in[opaque(7)] + l * D, (((const float*)(p.ws + (unsigned)opaque((int)WS_MOD))) + l * 3 * 6144), 2048, p.out, ((float*)(p.ws + (unsigned)opaque((int)WS_CTX))), p.in[opaque(8)] + l * D, (((const float*)(p.ws + (unsigned)opaque((int)WS_MOD))) + l * 3 * 6144), 3072, 4096, ((bf16_t*)(p.ws + (unsigned)opaque((int)WS_Y))), M, bid, G, ((float*)(p.ws + (unsigned)opaque((int)WS_SRET))), last ? 0 : 4);
        wconv_items(p, l, 2, lds, bid, G);
        if (l == 0) wconv_items(p, 1, 0, lds, bid, G);
        XBAR();
        { pg8::Gemm g{((bf16_t*)(p.ws + (unsigned)opaque((int)WS_Y))), (const bf16_t*)((p.ws + (unsigned)opaque(0)) + WS_WGU), opaque(M), opaque(NGU), opaque(D)}; pg8::StaticOrder S; S.init(g.M, g.N, G, bid); pg8::EpiSwiGLU E{((bf16_t*)(p.ws + (unsigned)opaque((int)WS_U))), FF};
          pg8::gemm_phase<pg8::EpiSwiGLU, pg8::StaticOrder>(lds, g, S, E, nullptr); }
        XBAR();
        { pg8::Gemm g{((bf16_t*)(p.ws + (unsigned)opaque((int)WS_U))), (const bf16_t*)((p.ws + (unsigned)opaque(0)) + WS_WDN), opaque(MLAT), opaque(D), opaque(FF)}; pg8::StaticOrder S; S.init(g.M, g.N, G, bid); pg8::EpiBf16<0> E{((bf16_t*)(p.ws + (unsigned)opaque((int)WS_C2))), D, nullptr, 0, 0};
          pg8::gemm_phase<pg8::EpiBf16<0>, pg8::StaticOrder>(lds, g, S, E, nullptr); }
        if (!last) ctx_gemm_items(((const bf16_t*)(p.ws + (unsigned)opaque((int)WS_U))) + (size_t)MLAT * FF, FF, (const bf16_t*)((p.ws + (unsigned)opaque(0)) + WS_WDN), FF, 11, ((float*)(p.ws + (unsigned)opaque((int)WS_SRET))), lds, bid, G);
        XBAR();
        row_phase(p.out, ((float*)(p.ws + (unsigned)opaque((int)WS_CTX))), ((const bf16_t*)(p.ws + (unsigned)opaque((int)WS_C2))), p.in[opaque(9)] + l * D, (((const float*)(p.ws + (unsigned)opaque((int)WS_MOD))) + l * 3 * 6144), 5120, p.out, ((float*)(p.ws + (unsigned)opaque((int)WS_CTX))), last ? nullptr : p.in[opaque(6)] + (l + 1) * D, ((const float*)(p.ws + (unsigned)opaque((int)WS_MOD))) + (l + 1) * 3 * 6144, 0, 1024, last ? nullptr : ((bf16_t*)(p.ws + (unsigned)opaque((int)WS_Y))), M, bid, G, ((float*)(p.ws + (unsigned)opaque((int)WS_SRET))), last ? 0 : 11);
        if (!last) XBAR();
    }
}

extern "C" void kernel_launch(void* const* d_in, const int* in_sizes, int n_in, void* d_out, int out_size, void* d_ws, size_t ws_size, hipStream_t stream) {
    static int grid_blocks = 0;
    if (!grid_blocks) {
        int dev = 0, cus = 0, per_cu = 0;
        (void)hipGetDevice(&dev);
        (void)hipDeviceGetAttribute(&cus, hipDeviceAttributeMultiprocessorCount, dev);
        if (hipFuncSetAttribute((const void*)fwd_kernel, hipFuncAttributeMaxDynamicSharedMemorySize, LDS_BYTES) != hipSuccess) fprintf(stderr, "hipFuncSetAttribute failed\n");
        if (hipOccupancyMaxActiveBlocksPerMultiprocessor(&per_cu, (const void*)fwd_kernel, 512, LDS_BYTES) != hipSuccess || per_cu < 1) { fprintf(stderr, "occupancy query: %d\n", per_cu); per_cu = 1; }
        (void)hipGetLastError();
        grid_blocks = cus;
        if (ws_size < WS_END) fprintf(stderr, "workspace too small: %zu < %zu\n", ws_size, (size_t)WS_END);
    }
    Params p{};
    for (int i = 0; i < 34; ++i) p.in[i] = (const float*)d_in[i];
    p.out = (float*)d_out; p.ws = (unsigned char*)d_ws;
    (void)hipMemsetAsync((char*)d_ws + WS_BAR, 0, CTL_WORDS * 4, stream);
    void* args[] = {&p};
    hipError_t e = hipLaunchCooperativeKernel((const void*)fwd_kernel, dim3(grid_blocks), dim3(512), args, LDS_BYTES, stream);
    if (e != hipSuccess) fprintf(stderr, "cooperative launch failed: %s (grid %d)\n", hipGetErrorString(e), grid_blocks);
}
```
